# Optimizing an MI355X kernel written in HIP

```python
import jax, jax.numpy as jnp
from jax import lax
import numpy as np

D_MODEL = 1024
BATCH = 2
SEQ = 8192
DEPTH = 4
DEC_BATCH = 2
DEC_SEQ = 16384
PAST_LEN = 128

HEAD_DIM = 64
NA_HEADS = 8
SWA_HEADS = 8
SWA_KV_HEADS = 2
SWA_GROUP = SWA_HEADS // SWA_KV_HEADS
NA_WIDTH = NA_HEADS * HEAD_DIM
SWA_WIDTH = SWA_HEADS * HEAD_DIM
SWA_KV_WIDTH = SWA_KV_HEADS * HEAD_DIM
MIX_WIDTH = NA_WIDTH + SWA_WIDTH
IN_WIDTH = 3 * NA_WIDTH + SWA_WIDTH + 2 * SWA_KV_WIDTH
D_FF = 4 * D_MODEL
GRID_W = 64
NA_ROWS_MAX = 8
NA_COLS = 16
WINDOW = 128
BLOCK = 128
ROPE_THETA = 10000.0
EPS = 1e-5
NEG = -1e30

kernel_name = "hybrid_na_swa_sink_encoder"


def rms_norm(x, g):
    xf = x.astype(jnp.float32)
    y = xf * lax.rsqrt(jnp.mean(xf * xf, axis=-1, keepdims=True) + EPS)
    return (y * g.astype(jnp.float32)).astype(x.dtype)


def rope(x):
    s = x.shape[1]
    half = HEAD_DIM // 2
    inv = ROPE_THETA ** (-jnp.arange(half, dtype=jnp.float32) / half)
    ang = jnp.arange(s, dtype=jnp.float32)[:, None] * inv[None, :]
    cos = jnp.cos(ang)[None, :, None, :]
    sin = jnp.sin(ang)[None, :, None, :]
    xf = x.astype(jnp.float32)
    x1, x2 = xf[..., :half], xf[..., half:]
    return jnp.concatenate([x1 * cos - x2 * sin, x2 * cos + x1 * sin], axis=-1).astype(x.dtype)


def neighbourhood_attention(q, k, v, rpb):
    b, s, h, dh = q.shape
    rows = s // GRID_W
    wr = min(NA_ROWS_MAX, rows)
    wc = NA_COLS
    qg = q.reshape(b, rows, GRID_W, h, dh)
    kg = k.reshape(b, rows, GRID_W, h, dh)
    vg = v.reshape(b, rows, GRID_W, h, dh)
    cols = np.arange(GRID_W)
    col_start = np.clip(cols - wc // 2, 0, GRID_W - wc)
    col_idx = col_start[:, None] + np.arange(wc)[None, :]
    dc_idx = col_idx - cols[:, None] + (NA_COLS - 1)
    scale = dh ** -0.5
    rpb_f = rpb.astype(jnp.float32)

    def one_row(r):
        rs = jnp.clip(r - wr // 2, 0, rows - wr)
        q_r = lax.dynamic_index_in_dim(qg, r, axis=1, keepdims=False)
        k_rows = lax.dynamic_slice_in_dim(kg, rs, wr, axis=1)
        v_rows = lax.dynamic_slice_in_dim(vg, rs, wr, axis=1)
        k_win = k_rows[:, :, col_idx]
        v_win = v_rows[:, :, col_idx]
        dr_idx = rs + jnp.arange(wr) - r + (NA_ROWS_MAX - 1)
        bias = rpb_f[:, dr_idx][:, :, dc_idx]
        sc = jnp.einsum('bchd,brcjhd->bhcrj', q_r, k_win,
                        preferred_element_type=jnp.float32) * scale
        sc = sc + jnp.transpose(bias, (0, 2, 1, 3))[None]
        p = jax.nn.softmax(sc.reshape(b, h, GRID_W, wr * wc), axis=-1)
        p = p.reshape(b, h, GRID_W, wr, wc).astype(v.dtype)
        return jnp.einsum('bhcrj,brcjhd->bchd', p, v_win)

    out = lax.map(one_row, jnp.arange(rows))
    return jnp.transpose(out, (1, 0, 2, 3, 4)).reshape(b, s, h, dh)


def sliding_window_attention(q, k, v, sink):
    b, s, hq, dh = q.shape
    hkv = k.shape[2]
    g = hq // hkv
    nb = s // BLOCK
    scale = dh ** -0.5
    qb = q.reshape(b, nb, BLOCK, hkv, g, dh)

    def band(t):
        pad = jnp.zeros((b, BLOCK, hkv, dh), t.dtype)
        tp = jnp.concatenate([pad, t, pad], axis=1).reshape(b, nb + 2, BLOCK, hkv, dh)
        return jnp.concatenate([tp[:, :-2], tp[:, 1:-1], tp[:, 2:]], axis=2)

    kb, vb = band(k), band(v)
    sc = jnp.einsum('bnqkgd,bnjkd->bnkgqj', qb, kb,
                    preferred_element_type=jnp.float32) * scale
    blk = jnp.arange(nb)
    qpos = blk[:, None] * BLOCK + jnp.arange(BLOCK)[None, :]
    kpos = (blk[:, None] - 1) * BLOCK + jnp.arange(3 * BLOCK)[None, :]
    diff = qpos[:, :, None] - kpos[:, None, :]
    valid = (jnp.abs(diff) <= WINDOW) & (kpos[:, None, :] >= 0) & (kpos[:, None, :] < s)
    sc = jnp.where(valid[None, :, None, None], sc, NEG)
    sink_l = sink.astype(jnp.float32).reshape(hkv, g)[None, None, :, :, None, None]
    m = jnp.maximum(jnp.max(sc, axis=-1, keepdims=True), sink_l)
    p = jnp.exp(sc - m)
    denom = jnp.sum(p, axis=-1, keepdims=True) + jnp.exp(sink_l - m)
    out = jnp.einsum('bnkgqj,bnjkd->bnqkgd', (p / denom).astype(v.dtype), vb)
    return out.reshape(b, s, hq, dh)


def mixer(h, w_in, rpb, sink, w_out):
    b, s, _ = h.shape
    proj = h @ w_in
    o1 = NA_WIDTH
    o2 = 2 * NA_WIDTH
    o3 = 3 * NA_WIDTH
    o4 = o3 + SWA_WIDTH
    o5 = o4 + SWA_KV_WIDTH
    qa, ka, va, qs, ks, vs = jnp.split(proj, [o1, o2, o3, o4, o5], axis=-1)
    qa = qa.reshape(b, s, NA_HEADS, HEAD_DIM)
    ka = ka.reshape(b, s, NA_HEADS, HEAD_DIM)
    va = va.reshape(b, s, NA_HEADS, HEAD_DIM)
    qs = rope(qs.reshape(b, s, SWA_HEADS, HEAD_DIM))
    ks = rope(ks.reshape(b, s, SWA_KV_HEADS, HEAD_DIM))
    vs = vs.reshape(b, s, SWA_KV_HEADS, HEAD_DIM)
    oa = neighbourhood_attention(qa, ka, va, rpb).reshape(b, s, NA_WIDTH)
    ob = sliding_window_attention(qs, ks, vs, sink).reshape(b, s, SWA_WIDTH)
    return jnp.concatenate([oa, ob], axis=-1) @ w_out


def trunk(x, norm_mix, w_in, rpb, sink, w_out, norm_mlp, w_up, w_down, norm_final):
    for l in range(DEPTH):
        x = x + mixer(rms_norm(x, norm_mix[l]), w_in[l], rpb[l], sink[l], w_out[l])
        hdn = rms_norm(x, norm_mlp[l]) @ w_up[l]
        x = x + jnp.square(jax.nn.relu(hdn)) @ w_down[l]
    return rms_norm(x, norm_final)


def setup_inputs(seed: int = 0) -> dict:
    key = jax.random.key(seed)
    ks = jax.random.split(key, 12)
    f32 = jnp.float32
    x_prompt = jax.random.normal(ks[0], (BATCH, SEQ, D_MODEL), f32)
    x_sample = jax.random.normal(ks[1], (DEC_BATCH, DEC_SEQ, D_MODEL), f32)
    norm_mix = 1.0 + 0.05 * jax.random.normal(ks[2], (DEPTH, D_MODEL), f32)
    w_in = jax.random.normal(ks[3], (DEPTH, D_MODEL, IN_WIDTH), f32) * D_MODEL ** -0.5
    rpb = 0.1 * jax.random.normal(ks[4], (DEPTH, NA_HEADS, 2 * NA_ROWS_MAX - 1, 2 * NA_COLS - 1), f32)
    sink = 0.5 * jax.random.normal(ks[5], (DEPTH, SWA_HEADS), f32)
    w_out = jax.random.normal(ks[6], (DEPTH, MIX_WIDTH, D_MODEL), f32) * MIX_WIDTH ** -0.5
    norm_mlp = 1.0 + 0.05 * jax.random.normal(ks[7], (DEPTH, D_MODEL), f32)
    w_up = jax.random.normal(ks[8], (DEPTH, D_MODEL, D_FF), f32) * D_MODEL ** -0.5
    w_down = jax.random.normal(ks[9], (DEPTH, D_FF, D_MODEL), f32) * D_FF ** -0.5
    norm_final = 1.0 + 0.05 * jax.random.normal(ks[10], (D_MODEL,), f32)
    return {"x_prompt": x_prompt, "x_sample": x_sample, "norm_mix": norm_mix, "w_in": w_in,
            "rpb": rpb, "sink": sink, "w_out": w_out, "norm_mlp": norm_mlp, "w_up": w_up,
            "w_down": w_down, "norm_final": norm_final}


def reference(x_prompt, x_sample, norm_mix, w_in, rpb, sink, w_out, norm_mlp, w_up, w_down, norm_final):
    y_prompt = trunk(x_prompt, norm_mix, w_in, rpb, sink, w_out, norm_mlp, w_up, w_down, norm_final)
    y_sample = trunk(x_sample, norm_mix, w_in, rpb, sink, w_out, norm_mlp, w_up, w_down, norm_final)
    return (y_prompt, y_sample)
```

```cpp
#include <hip/hip_runtime.h>
#include <hip/hip_cooperative_groups.h>
#include <cstdio>
#include <cstdint>
#include <cmath>
namespace cg = cooperative_groups;

#define LAS __attribute__((address_space(3)))
typedef unsigned short bf16_t;
typedef short bf16x8 __attribute__((ext_vector_type(8)));
typedef short s16x4 __attribute__((ext_vector_type(4)));
typedef float f32x4 __attribute__((ext_vector_type(4)));
typedef float f32x2 __attribute__((ext_vector_type(2)));
typedef unsigned u32x4 __attribute__((ext_vector_type(4)));
typedef unsigned u32x2 __attribute__((ext_vector_type(2)));
typedef __bf16 bf16x2_t __attribute__((ext_vector_type(2)));

constexpr int D = 1024, DEPTH = 4, NIN = 2304, FF = 4096;
constexpr int M_TOT = 49152, M_SPLIT = 16384;
constexpr int NCHUNK = 3, CHUNK_ROWS = M_TOT / NCHUNK;
constexpr float EPS = 1e-5f;
constexpr float LOG2E = 1.4426950408889634f;
constexpr float QSCALE = 0.125f * LOG2E;
constexpr int C_QA = 0, C_QS = 512, C_KA = 1024, C_VA = 1536, C_KS = 2048, C_VS = 2176;

constexpr size_t MiB = 1u << 20;
constexpr size_t WS_ROPE = 1 * MiB;
constexpr size_t WS_SSQ = 5 * MiB;
constexpr size_t WS_WIN = 8 * MiB;
constexpr size_t WS_WOUT = 26 * MiB;
constexpr size_t WS_WUP = 34 * MiB;
constexpr size_t WS_WDN = 66 * MiB;
constexpr size_t WS_XB = 98 * MiB;
constexpr size_t WS_QKV = 194 * MiB;
constexpr size_t WS_H = 194 * MiB;
constexpr size_t WS_END = 410 * MiB;

constexpr int KROW = 144;
constexpr int LDS_KS = 0, LDS_VS = 512 * KROW, LDS_BIAS = 2 * 512 * KROW, LDS_XM = LDS_BIAS + 2048, LDS_TOTAL = LDS_XM + 1024;
constexpr int LDS_BYTES = 151552;

__device__ __forceinline__ unsigned cvtpk(float lo, float hi) { f32x2 v = {lo, hi}; bf16x2_t b = __builtin_convertvector(v, bf16x2_t); return __builtin_bit_cast(unsigned, b); }
__device__ __forceinline__ float wave_sum(float v) {
#pragma unroll
    for (int o = 1; o < 64; o <<= 1) v += __shfl_xor(v, o);
    return v;
}

namespace pg8 {
constexpr int BM = 256, BK = 64, HALF = 128, HTB = HALF * BK * 2, STAGE_BYTES = 8 * HTB, NXCD = 8, WGM = 8;
__host__ __device__ __forceinline__ int lds_byte(int r, int c) { const int st = (r >> 4) * 2 + (c >> 5), rr = r & 15, cc = c & 31, ob = rr * 64 + cc * 2; return st * 1024 + (ob ^ (((ob >> 9) & 1) << 5)); }
__host__ __device__ __forceinline__ void stage_rc(int b, int& R, int& C) { const int st = b / 1024, sb = b % 1024, swz = sb ^ (((sb >> 9) & 1) << 5); R = (st >> 1) * 16 + swz / 64; C = (st & 1) * 32 + (swz % 64) / 2; }
__host__ __device__ __forceinline__ int perm32(int rho) { const int n = rho >> 4, i = rho & 15; return 8 * (i >> 2) + 4 * n + (i & 3); }

struct Unit { int pm, pn; };
struct Gemm { const bf16_t* A; const bf16_t* Bt; int M, N, K, lda, ldb; };

struct StaticOrder {
    int nM, nN, nwg, G, c;
    __device__ void init(int M, int N, int G_, int c_) { nM = M / BM; nN = N / BM; nwg = nM * nN; G = G_; c = c_; }
    __device__ bool next(int i, Unit& u) const {
        const long L = (long)i * G + c; if (L >= nwg) return false;
        int wgid = (int)L; { const int q = nwg / NXCD, r = nwg % NXCD, xcd = wgid % NXCD, off = wgid / NXCD; wgid = (xcd < r ? xcd * (q + 1) : r * (q + 1) + (xcd - r) * q) + off; }
        const int nig = WGM * nN, gid = wgid / nig, fm = gid * WGM, gsz = (nM - fm) < WGM ? (nM - fm) : WGM;
        u.pm = fm + ((wgid % nig) % gsz); u.pn = (wgid % nig) / gsz; return true;
    }
};

template <class Epi>
__device__ __forceinline__ void gemm_phase(LAS unsigned char* lds, const Gemm g, const StaticOrder& S, const Epi& E) {
    int tid = threadIdx.x; asm volatile("" : "+v"(tid));
    const int wid = __builtin_amdgcn_readfirstlane(tid >> 6), lane = tid & 63, wr = wid >> 2, wc = wid & 3, fr = lane & 15, fq = lane >> 4;
    const int K = g.K, nt = K / BK;
    unsigned voffA[2], voffB[2];
#pragma unroll
    for (int i = 0; i < 2; ++i) { int R, C; stage_rc(tid * 16 + i * 8192, R, C); const int Rb = Epi::PERM ? ((R & ~31) + perm32(R & 31)) : R;
        voffA[i] = (unsigned)(R * g.lda + C) * 2u; voffB[i] = (unsigned)(Rb * g.ldb + C) * 2u; }
    const size_t kstep = (size_t)(BK * 2);
    const size_t hstepA = (size_t)HALF * g.lda * 2, hstepB = (size_t)HALF * g.ldb * 2;
    const size_t tstepA = 2 * hstepA, tstepB = 2 * hstepB;
    const unsigned ldsw = (unsigned)wid * 1024u;
    const int aoff = lds_byte(wr * 64 + fr, fq * 8), boff = lds_byte(wc * 32 + fr, fq * 8);
#define PG8_SA(b, h) (((b) * 2 + (h)) * HTB)
#define PG8_SB(b, h) ((4 + (b) * 2 + (h)) * HTB)
#define PG8_STAGE(bufoff, gbase, voff) do { _Pragma("unroll") for (int _i = 0; _i < 2; ++_i) \
        __builtin_amdgcn_global_load_lds((const unsigned*)((const char*)(gbase) + (voff)[_i]), (LAS unsigned*)(lds + (bufoff) + ldsw + _i * 8192), 16, 0, 0); } while (0)
#define PG8_LDA(dst, b, h) do { _Pragma("unroll") for (int m = 0; m < 4; ++m) _Pragma("unroll") for (int k = 0; k < 2; ++k) dst[m][k] = *(const LAS bf16x8*)(lds + PG8_SA(b, h) + aoff + m * 2048 + k * 1024); } while (0)
#define PG8_LDB(dst, b, h) do { _Pragma("unroll") for (int n = 0; n < 2; ++n) _Pragma("unroll") for (int k = 0; k < 2; ++k) dst[n][k] = *(const LAS bf16x8*)(lds + PG8_SB(b, h) + boff + n * 2048 + k * 1024); } while (0)
#define PG8_MMA(ai, bj, At, Bt) do { __builtin_amdgcn_s_setprio(1); _Pragma("unroll") for (int m = 0; m < 4; ++m) _Pragma("unroll") for (int n = 0; n < 2; ++n) _Pragma("unroll") for (int k = 0; k < 2; ++k) \
        acc[ai][bj][m][n] = __builtin_amdgcn_mfma_f32_16x16x32_bf16(Bt[n][k], At[m][k], acc[ai][bj][m][n], 0, 0, 0); __builtin_amdgcn_s_setprio(0); } while (0)
#define PG8_WAIT_V(n) asm volatile("s_waitcnt vmcnt(" #n ")" ::: "memory")
#define PG8_WAIT_L(n) asm volatile("s_waitcnt lgkmcnt(" #n ")" ::: "memory")
#define PG8_BAR __builtin_amdgcn_s_barrier()
#define PG8_SCHED __builtin_amdgcn_sched_barrier(0)
    Unit cur, nxt; int ui = 0;
    if (!S.next(0, cur)) return;
    f32x4 acc[2][2][4][2];
#pragma unroll
    for (int a = 0; a < 2; ++a)
#pragma unroll
        for (int b = 0; b < 2; ++b)
#pragma unroll
            for (int m = 0; m < 4; ++m)
#pragma unroll
                for (int n = 0; n < 2; ++n) acc[a][b][m][n] = (f32x4){0.f, 0.f, 0.f, 0.f};
    bf16x8 At[4][2], B0[2][2], B1[2][2];
    const char* cA = (const char*)g.A + (size_t)cur.pm * tstepA; const char* cB = (const char*)g.Bt + (size_t)cur.pn * tstepB;
    PG8_STAGE(PG8_SB(0, 0), cB, voffB); PG8_STAGE(PG8_SB(0, 1), cB + hstepB, voffB); PG8_STAGE(PG8_SA(0, 0), cA, voffA); PG8_STAGE(PG8_SA(0, 1), cA + hstepA, voffA);
    if (wr == 1) PG8_BAR;
    PG8_WAIT_V(2); PG8_BAR;
    PG8_STAGE(PG8_SB(1, 0), cB + kstep, voffB); PG8_STAGE(PG8_SA(1, 0), cA + kstep, voffA); PG8_STAGE(PG8_SB(1, 1), cB + hstepB + kstep, voffB);
    PG8_WAIT_V(6); PG8_BAR;
    for (;;) {
        const bool has_next = S.next(ui + 1, nxt);
        const char* nA = has_next ? (const char*)g.A + (size_t)nxt.pm * tstepA : cA; const char* nB = has_next ? (const char*)g.Bt + (size_t)nxt.pn * tstepB : cB;
        for (int t = 0; t < nt; t += 2) {
            const bool last = (t == nt - 2);
            const char* a1 = cA + (size_t)(t + 1) * kstep;
            const char* a2 = last ? nA : cA + (size_t)(t + 2) * kstep; const char* b2 = last ? nB : cB + (size_t)(t + 2) * kstep;
            const char* a3 = a2 + kstep; const char* b3 = b2 + kstep;
            PG8_LDB(B0, 0, 0); PG8_LDB(B1, 0, 1); PG8_SCHED; PG8_LDA(At, 0, 0); PG8_STAGE(PG8_SA(1, 1), a1 + hstepA, voffA);
            PG8_WAIT_V(8); PG8_WAIT_L(0); PG8_BAR; PG8_MMA(0, 0, At, B0); PG8_MMA(0, 1, At, B1); PG8_BAR; PG8_SCHED;
            PG8_LDA(At, 0, 1); PG8_STAGE(PG8_SB(0, 0), b2, voffB); PG8_STAGE(PG8_SB(0, 1), b2 + hstepB, voffB); PG8_STAGE(PG8_SA(0, 0), a2, voffA);
            PG8_WAIT_V(8); PG8_WAIT_L(0); PG8_BAR; PG8_MMA(1, 0, At, B0); PG8_MMA(1, 1, At, B1); PG8_BAR; PG8_SCHED;
            PG8_LDB(B0, 1, 0); PG8_LDB(B1, 1, 1); PG8_SCHED; PG8_LDA(At, 1, 0); PG8_STAGE(PG8_SA(0, 1), a2 + hstepA, voffA);
            PG8_WAIT_V(8); PG8_WAIT_L(0); PG8_BAR; PG8_MMA(0, 0, At, B0); PG8_MMA(0, 1, At, B1); PG8_BAR; PG8_SCHED;
            PG8_LDA(At, 1, 1); PG8_STAGE(PG8_SB(1, 0), b3, voffB); PG8_STAGE(PG8_SB(1, 1), b3 + hstepB, voffB); PG8_STAGE(PG8_SA(1, 0), a3, voffA);
            PG8_WAIT_V(8); PG8_WAIT_L(0); PG8_BAR; PG8_MMA(1, 0, At, B0); PG8_MMA(1, 1, At, B1); PG8_BAR; PG8_SCHED;
        }
        if (wr == 0) PG8_BAR;
        E(acc, cur, wr, wc, fr, fq);
        if (!has_next) break;
#pragma unroll
        for (int a = 0; a < 2; ++a)
#pragma unroll
            for (int b = 0; b < 2; ++b)
#pragma unroll
                for (int m = 0; m < 4; ++m)
#pragma unroll
                    for (int n = 0; n < 2; ++n) acc[a][b][m][n] = (f32x4){0.f, 0.f, 0.f, 0.f};
        cur = nxt; cA = nA; cB = nB; ++ui;
        if (wr == 1) PG8_BAR;
    }
    PG8_WAIT_V(0);
    PG8_BAR;
#undef PG8_SA
#undef PG8_SB
#undef PG8_STAGE
#undef PG8_LDA
#undef PG8_LDB
#undef PG8_MMA
#undef PG8_WAIT_V
#undef PG8_WAIT_L
#undef PG8_BAR
#undef PG8_SCHED
}
}

__device__ __forceinline__ float row_rstd(const float* ssq, int row, int fq) {
    const f32x4 sp = *(const f32x4*)(ssq + (size_t)row * 16 + fq * 4);
    float s = (sp.x + sp.y) + (sp.z + sp.w);
    s += __shfl_xor(s, 16); s += __shfl_xor(s, 32);
    return rsqrtf(s * (1.0f / D) + EPS);
}
struct EpiQKV {
    static constexpr bool PERM = true;
    bf16_t* O; const float* ssq; const f32x4* rope;
    __device__ __forceinline__ void operator()(const f32x4 (&acc)[2][2][4][2], const pg8::Unit& u, int wr, int wc, int fr, int fq) const {
        const int pn = u.pn;
        const float qs = (pn < 4) ? QSCALE : 1.f;
        const int col0 = pn * 256 + wc * 32 + 8 * fq;
        const int i0h = 8 * (wc & 1) + 2 * fq;
#pragma unroll
        for (int ai = 0; ai < 2; ++ai)
#pragma unroll
            for (int m = 0; m < 4; ++m) {
                const int row = u.pm * 256 + ai * 128 + wr * 64 + m * 16 + fr;
                const float rs = row_rstd(ssq, row, fq) * qs;
                const int pos = row < M_SPLIT ? (row & 8191) : (row & 16383);
                bf16_t* rowp = O + (size_t)row * NIN + col0;
#pragma unroll
                for (int bj = 0; bj < 2; ++bj) {
                    f32x4 v0 = acc[ai][bj][m][0] * rs, v1 = acc[ai][bj][m][1] * rs;
                    const bool do_rope = (pn == 2) || (pn == 3) || (pn == 8 && bj == 0);
                    if (do_rope) {
                        const f32x4* rp = rope + (size_t)pos * 16 + i0h;
                        const f32x4 r0 = rp[0], r1 = rp[1];
                        v0 = (f32x4){v0.x * r0.x - v0.y * r0.y, v0.y * r0.x + v0.x * r0.y, v0.z * r0.z - v0.w * r0.w, v0.w * r0.z + v0.z * r0.w};
                        v1 = (f32x4){v1.x * r1.x - v1.y * r1.y, v1.y * r1.x + v1.x * r1.y, v1.z * r1.z - v1.w * r1.w, v1.w * r1.z + v1.z * r1.w};
                    }
                    u32x4 w; w.x = cvtpk(v0.x, v0.y); w.y = cvtpk(v0.z, v0.w); w.z = cvtpk(v1.x, v1.y); w.w = cvtpk(v1.z, v1.w);
                    *(u32x4*)(rowp + bj * 128) = w;
                }
            }
    }
};
struct EpiUp {
    static constexpr bool PERM = true;
    bf16_t* O; const float* ssq; int row0;
    __device__ __forceinline__ void operator()(const f32x4 (&acc)[2][2][4][2], const pg8::Unit& u, int wr, int wc, int fr, int fq) const {
        const int col0 = u.pn * 256 + wc * 32 + 8 * fq;
#pragma unroll
        for (int ai = 0; ai < 2; ++ai)
#pragma unroll
            for (int m = 0; m < 4; ++m) {
                const int rl = u.pm * 256 + ai * 128 + wr * 64 + m * 16 + fr;
                const float rs = row_rstd(ssq, row0 + rl, fq);
                bf16_t* rowp = O + (size_t)rl * FF + col0;
#pragma unroll
                for (int bj = 0; bj < 2; ++bj) {
                    f32x4 v0 = acc[ai][bj][m][0] * rs, v1 = acc[ai][bj][m][1] * rs;
                    v0 = __builtin_elementwise_max(v0, (f32x4){0.f, 0.f, 0.f, 0.f}); v1 = __builtin_elementwise_max(v1, (f32x4){0.f, 0.f, 0.f, 0.f});
                    v0 = v0 * v0; v1 = v1 * v1;
                    u32x4 w; w.x = cvtpk(v0.x, v0.y); w.y = cvtpk(v0.z, v0.w); w.z = cvtpk(v1.x, v1.y); w.w = cvtpk(v1.z, v1.w);
                    *(u32x4*)(rowp + bj * 128) = w;
                }
            }
    }
};
struct EpiRes {
    static constexpr bool PERM = false;
    const float* base0; const float* base1; float* out; bf16_t* xb; float* ssq; int row0;
    __device__ __forceinline__ void operator()(const f32x4 (&acc)[2][2][4][2], const pg8::Unit& u, int wr, int wc, int fr, int fq) const {
        const int col0 = u.pn * 256 + wc * 32 + 4 * fq;
#pragma unroll
        for (int ai = 0; ai < 2; ++ai)
#pragma unroll
            for (int m = 0; m < 4; ++m) {
                const int row = row0 + u.pm * 256 + ai * 128 + wr * 64 + m * 16 + fr;
                const float* bp = (row < M_SPLIT ? base0 + (size_t)row * D : base1 + (size_t)(row - M_SPLIT) * D) + col0;
                float* op = out + (size_t)row * D + col0; bf16_t* xp = xb + (size_t)row * D + col0;
                float s = 0.f;
#pragma unroll
                for (int bj = 0; bj < 2; ++bj)
#pragma unroll
                    for (int n = 0; n < 2; ++n) {
                        const f32x4 b = *(const f32x4*)(bp + bj * 128 + n * 16);
                        const f32x4 v = b + acc[ai][bj][m][n];
                        *(f32x4*)(op + bj * 128 + n * 16) = v;
                        s += (v.x * v.x + v.y * v.y) + (v.z * v.z + v.w * v.w);
                        u32x2 w; w.x = cvtpk(v.x, v.y); w.y = cvtpk(v.z, v.w);
                        *(u32x2*)(xp + bj * 128 + n * 16) = w;
                    }
                s += __shfl_xor(s, 16); s += __shfl_xor(s, 32);
                if (fq == 0) ssq[(size_t)row * 16 + u.pn * 4 + wc] = s;
            }
    }
};

__device__ __forceinline__ f32x4 mfma16(bf16x8 a, bf16x8 b, f32x4 c) { return __builtin_amdgcn_mfma_f32_16x16x32_bf16(a, b, c, 0, 0, 0); }
typedef short v4i16_t __attribute__((ext_vector_type(4)));
__device__ __forceinline__ s16x4 tr_read(LAS unsigned char* p) { return __builtin_bit_cast(s16x4, __builtin_amdgcn_ds_read_tr16_b64_v4i16((LAS v4i16_t*)p)); }
__device__ __forceinline__ bf16x8 pack_p(const f32x4& a, const f32x4& b) {
    u32x4 w; w.x = cvtpk(a.x, a.y); w.y = cvtpk(a.z, a.w); w.z = cvtpk(b.x, b.y); w.w = cvtpk(b.z, b.w); return __builtin_bit_cast(bf16x8, w);
}
__device__ __forceinline__ void pv_pair(f32x4 (&o)[4], LAS unsigned char* vaddr, bf16x8 pf) {
#pragma unroll
    for (int db = 0; db < 4; ++db) {
        const s16x4 a = tr_read(vaddr + db * 32), b = tr_read(vaddr + 16 * KROW + db * 32);
        const bf16x8 vf = (bf16x8){a[0], a[1], a[2], a[3], b[0], b[1], b[2], b[3]};
        o[db] = mfma16(vf, pf, o[db]);
    }
}

__device__ __forceinline__ void na_unit(LAS unsigned char* lds, bf16_t* QKV, const float* rpb_l, int h, int g) {
    int tid = threadIdx.x; asm volatile("" : "+v"(tid));
    const int lane = tid & 63, w = __builtin_amdgcn_readfirstlane(tid >> 6);
    const int glo = g < 128 ? 0 : (g < 256 ? 128 : (g < 512 ? 256 : 512));
    const int rows = g < 256 ? 128 : 256;
    int rs = g - 4; rs = rs < glo ? glo : rs; rs = rs > glo + rows - 8 ? glo + rows - 8 : rs;
    {
        const bf16_t* kb = QKV + (size_t)rs * 64 * NIN + C_KA + 64 * h;
        u32x4 kr[8], vr[8];
#pragma unroll
        for (int i = 0; i < 8; ++i) { const int idx = tid + 512 * i, kidx = idx >> 3, ch = idx & 7; const bf16_t* p = kb + (size_t)kidx * NIN + ch * 8;
            kr[i] = *(const u32x4*)p; vr[i] = *(const u32x4*)(p + (C_VA - C_KA)); }
#pragma unroll
        for (int i = 0; i < 8; ++i) { const int idx = tid + 512 * i, kidx = idx >> 3, ch = idx & 7;
            *(LAS u32x4*)(lds + LDS_KS + kidx * KROW + ch * 16) = kr[i]; *(LAS u32x4*)(lds + LDS_VS + kidx * KROW + ch * 16) = vr[i]; }
    }
    LAS float* bias = (LAS float*)(lds + LDS_BIAS);
    if (tid < 465) bias[tid] = rpb_l[h * 465 + tid] * LOG2E;
    const int jc = w & 3, half = w >> 2, n = lane & 15, q4 = lane >> 4;
    bf16_t* qp = QKV + ((size_t)g * 64 + 16 * jc + n) * NIN + C_QA + 64 * h;
    const bf16x8 qf0 = *(const bf16x8*)(qp + 8 * q4), qf1 = *(const bf16x8*)(qp + 32 + 8 * q4);
    __syncthreads();
    const int cb = jc == 0 ? 0 : (jc == 1 ? 8 : (jc == 2 ? 24 : 32));
    f32x4 s[4][2];
#pragma unroll
    for (int jr = 0; jr < 4; ++jr)
#pragma unroll
        for (int t = 0; t < 2; ++t) {
            const LAS unsigned char* kp = lds + LDS_KS + (64 * (4 * half + jr) + cb + 16 * t + n) * KROW + q4 * 16;
            const bf16x8 k0 = *(const LAS bf16x8*)kp, k1 = *(const LAS bf16x8*)(kp + 64);
            f32x4 z = (f32x4){0.f, 0.f, 0.f, 0.f};
            z = mfma16(k0, qf0, z); z = mfma16(k1, qf1, z);
            s[jr][t] = z;
        }
    const int c = 16 * jc + n; int cs = c - 8; cs = cs < 0 ? 0 : cs; cs = cs > 48 ? 48 : cs;
    float mx = -1e30f;
#pragma unroll
    for (int jr = 0; jr < 4; ++jr) {
        const int brow = (rs + 4 * half + jr - g + 7) * 31;
#pragma unroll
        for (int t = 0; t < 2; ++t)
#pragma unroll
            for (int i = 0; i < 4; ++i) {
                const int kc = cb + 16 * t + 4 * q4 + i;
                const bool valid = (kc >= cs) && (kc < cs + 16);
                const float bv = bias[valid ? brow + (kc - c + 15) : 0];
                const float v = valid ? s[jr][t][i] + bv : -1e30f;
                s[jr][t][i] = v; mx = fmaxf(mx, v);
            }
    }
    mx = fmaxf(mx, __shfl_xor(mx, 16)); mx = fmaxf(mx, __shfl_xor(mx, 32));
    LAS float* xm = (LAS float*)(lds + LDS_XM);
    if (q4 == 0) xm[w * 16 + n] = mx;
    __syncthreads();
    mx = fmaxf(mx, xm[(w ^ 4) * 16 + n]);
    float l = 0.f;
#pragma unroll
    for (int jr = 0; jr < 4; ++jr)
#pragma unroll
        for (int t = 0; t < 2; ++t)
#pragma unroll
            for (int i = 0; i < 4; ++i) { const float p = __builtin_amdgcn_exp2f(s[jr][t][i] - mx); s[jr][t][i] = p; l += p; }
    l += __shfl_xor(l, 16); l += __shfl_xor(l, 32);
    f32x4 o[4];
#pragma unroll
    for (int db = 0; db < 4; ++db) o[db] = (f32x4){0.f, 0.f, 0.f, 0.f};
#pragma unroll
    for (int jr = 0; jr < 4; ++jr) {
        LAS unsigned char* va = lds + LDS_VS + (64 * (4 * half + jr) + cb + 4 * q4 + (n >> 2)) * KROW + (n & 3) * 8;
        pv_pair(o, va, pack_p(s[jr][0], s[jr][1]));
    }
    LAS float* scr = (LAS float*)(lds + LDS_KS) + (w & 3) * (17 * 64);
    if (half == 1) {
#pragma unroll
        for (int db = 0; db < 4; ++db)
#pragma unroll
            for (int i = 0; i < 4; ++i) scr[(db * 4 + i) * 64 + lane] = o[db][i];
        scr[16 * 64 + lane] = l;
    }
    __syncthreads();
    if (half == 0) {
        l += scr[16 * 64 + lane];
        const float inv = 1.0f / l;
#pragma unroll
        for (int db = 0; db < 4; ++db) {
            f32x4 v = o[db];
#pragma unroll
            for (int i = 0; i < 4; ++i) v[i] = (v[i] + scr[(db * 4 + i) * 64 + lane]) * inv;
            u32x2 wv; wv.x = cvtpk(v.x, v.y); wv.y = cvtpk(v.z, v.w);
            *(u32x2*)(qp + 16 * db + 4 * q4) = wv;
        }
    }
    __syncthreads();
}

__device__ __forceinline__ void swa_unit(LAS unsigned char* lds, bf16_t* QKV, const float* sink_l, int kvh, int pb) {
    int tid = threadIdx.x; asm volatile("" : "+v"(tid));
    const int lane = tid & 63, w = __builtin_amdgcn_readfirstlane(tid >> 6);
    const int P0 = 32 * pb;
    const int slo = P0 < 8192 ? 0 : (P0 < 16384 ? 8192 : (P0 < 32768 ? 16384 : 32768));
    const int shi = P0 < 8192 ? 8192 : (P0 < 16384 ? 16384 : (P0 < 32768 ? 32768 : 49152));
    {
        u32x4 kr[5], vr[5];
#pragma unroll
        for (int i = 0; i < 5; ++i) { const int idx = tid + 512 * i, kidx = idx >> 3, ch = idx & 7; const int tok = P0 - 128 + kidx;
            const bool ok = (idx < 304 * 8) && tok >= slo && tok < shi;
            const bf16_t* p = QKV + (size_t)(ok ? tok : P0) * NIN + C_KS + 64 * kvh + ch * 8;
            const u32x4 z = (u32x4){0u, 0u, 0u, 0u};
            const u32x4 a = *(const u32x4*)p, b = *(const u32x4*)(p + (C_VS - C_KS));
            kr[i] = ok ? a : z; vr[i] = ok ? b : z; }
#pragma unroll
        for (int i = 0; i < 5; ++i) { const int idx = tid + 512 * i, kidx = idx >> 3, ch = idx & 7;
            if (idx < 304 * 8) { *(LAS u32x4*)(lds + LDS_KS + kidx * KROW + ch * 16) = kr[i]; *(LAS u32x4*)(lds + LDS_VS + kidx * KROW + ch * 16) = vr[i]; } }
    }
    const int hq = 4 * kvh + (w & 3), pg = w >> 2, n = lane & 15, q4 = lane >> 4;
    const int p0 = P0 + 16 * pg;
    bf16_t* qp = QKV + (size_t)(p0 + n) * NIN + C_QS + 64 * hq;
    const bf16x8 qf0 = *(const bf16x8*)(qp + 8 * q4), qf1 = *(const bf16x8*)(qp + 32 + 8 * q4);
    const float sinkv = sink_l[hq] * LOG2E;
    __syncthreads();
    f32x4 s[9][2];
#pragma unroll
    for (int j = 0; j < 9; ++j)
#pragma unroll
        for (int t = 0; t < 2; ++t) {
            const LAS unsigned char* kp = lds + LDS_KS + (16 * pg + 32 * j + 16 * t + n) * KROW + q4 * 16;
            const bf16x8 k0 = *(const LAS bf16x8*)kp, k1 = *(const LAS bf16x8*)(kp + 64);
            f32x4 z = (f32x4){0.f, 0.f, 0.f, 0.f};
            z = mfma16(k0, qf0, z); z = mfma16(k1, qf1, z);
            s[j][t] = z;
        }
    float mx = -1e30f;
#pragma unroll
    for (int j = 0; j < 9; ++j)
#pragma unroll
        for (int t = 0; t < 2; ++t)
#pragma unroll
            for (int i = 0; i < 4; ++i) {
                const int dl = 32 * j + 16 * t + 4 * q4 + i - 128 - n;
                const int key = p0 + n + dl;
                const bool valid = (dl >= -128) && (dl <= 128) && (key >= slo) && (key < shi);
                const float v = valid ? s[j][t][i] : -1e30f;
                s[j][t][i] = v; mx = fmaxf(mx, v);
            }
    mx = fmaxf(mx, __shfl_xor(mx, 16)); mx = fmaxf(mx, __shfl_xor(mx, 32));
    mx = fmaxf(mx, sinkv);
    float l = 0.f;
#pragma unroll
    for (int j = 0; j < 9; ++j)
#pragma unroll
        for (int t = 0; t < 2; ++t)
#pragma unroll
            for (int i = 0; i < 4; ++i) { const float p = __builtin_amdgcn_exp2f(s[j][t][i] - mx); s[j][t][i] = p; l += p; }
    l += __shfl_xor(l, 16); l += __shfl_xor(l, 32);
    l += __builtin_amdgcn_exp2f(sinkv - mx);
    f32x4 o[4];
#pragma unroll
    for (int db = 0; db < 4; ++db) o[db] = (f32x4){0.f, 0.f, 0.f, 0.f};
#pragma unroll
    for (int j = 0; j < 9; ++j) {
        LAS unsigned char* va = lds + LDS_VS + (16 * pg + 32 * j + 4 * q4 + (n >> 2)) * KROW + (n & 3) * 8;
        pv_pair(o, va, pack_p(s[j][0], s[j][1]));
    }
    const float inv = 1.0f / l;
#pragma unroll
    for (int db = 0; db < 4; ++db) {
        const f32x4 v = o[db] * inv;
        u32x2 wv; wv.x = cvtpk(v.x, v.y); wv.y = cvtpk(v.z, v.w);
        *(u32x2*)(qp + 16 * db + 4 * q4) = wv;
    }
    __syncthreads();
}

__device__ __forceinline__ int win_src(int n) {
    if (n < 512) return n;
    if (n < 1024) { const int p = n - 512, pp = p & 63; return 1536 + (p & ~63) + (pp >> 1) + ((pp & 1) << 5); }
    if (n < 1536) return 512 + (n - 1024);
    if (n < 2048) return 1024 + (n - 1536);
    if (n < 2176) { const int p = n - 2048, pp = p & 63; return 2048 + (p & ~63) + (pp >> 1) + ((pp & 1) << 5); }
    return n;
}
__device__ __forceinline__ void transpose_item(const float* W, int K, int N, bf16_t* WT, const float* gain, bool inmap, LAS float* scr, int item, int lane) {
    const int nblk = N / 32, kb = item / nblk, nb = item % nblk, k0 = 64 * kb, n0 = 32 * nb;
    const int nphys = n0 + (lane & 31), src = inmap ? win_src(nphys) : nphys;
#pragma unroll 8
    for (int i = 0; i < 32; ++i) { const int kk = 2 * i + (lane >> 5); const float gv = gain ? gain[k0 + kk] : 1.f; scr[kk * 33 + (lane & 31)] = W[(size_t)(k0 + kk) * N + src] * gv; }
    asm volatile("s_waitcnt lgkmcnt(0)" ::: "memory");
    const int c = lane & 7;
#pragma unroll
    for (int j = 0; j < 4; ++j) { const int n = (lane >> 3) + 8 * j; const LAS float* s = scr + (8 * c) * 33 + n;
        u32x4 o; o.x = cvtpk(s[0 * 33], s[1 * 33]); o.y = cvtpk(s[2 * 33], s[3 * 33]); o.z = cvtpk(s[4 * 33], s[5 * 33]); o.w = cvtpk(s[6 * 33], s[7 * 33]);
        *(u32x4*)(WT + (size_t)(n0 + n) * K + k0 + 8 * c) = o; }
    asm volatile("s_waitcnt lgkmcnt(0)" ::: "memory");
}
__device__ __forceinline__ void sincos_acc(float ang, float& co, float& si) {
    const double a = (double)ang;
    const double q = __builtin_rint(a * 0.63661977236758134308);
    double r = __builtin_fma(-q, 1.57079632679489655800e+00, a); r = __builtin_fma(-q, 6.12323399573676603587e-17, r);
    const double r2 = r * r;
    double sp = -2.50521083854417187751e-08; sp = sp * r2 + 2.75573192239858906526e-06; sp = sp * r2 - 1.98412698412698412698e-04; sp = sp * r2 + 8.33333333333333333333e-03; sp = sp * r2 - 1.66666666666666666667e-01;
    const double sn = r + r * r2 * sp;
    double cp = 2.08767569878680989792e-09; cp = cp * r2 - 2.75573192239858906526e-07; cp = cp * r2 + 2.48015873015873015873e-05; cp = cp * r2 - 1.38888888888888888889e-03; cp = cp * r2 + 4.16666666666666666667e-02; cp = cp * r2 - 0.5;
    const double cn = 1.0 + r2 * cp;
    const int qi = ((int)q) & 3;
    const double c2 = (qi == 0) ? cn : (qi == 1) ? -sn : (qi == 2) ? -cn : sn;
    const double s2 = (qi == 0) ? sn : (qi == 1) ? cn : (qi == 2) ? -sn : -cn;
    co = (float)c2; si = (float)s2;
}

struct Args {
    const float* xp; const float* xs; const float* norm_mix; const float* w_in; const float* rpb; const float* sink; const float* w_out;
    const float* norm_mlp; const float* w_up; const float* w_down; const float* norm_final;
    float* out; unsigned char* ws;
    float inv_freq[32];
};

__global__ void __launch_bounds__(512, 2) mega_fwd(Args a) {
    extern __shared__ __attribute__((aligned(16))) unsigned char lds_raw[];
    LAS unsigned char* lds = (LAS unsigned char*)lds_raw;
    cg::grid_group grid = cg::this_grid();
    const int tid = threadIdx.x, lane = tid & 63, wave = __builtin_amdgcn_readfirstlane(tid >> 6);
    const int G = gridDim.x, bx = blockIdx.x;
    const int gw = bx * 8 + wave, NGW = G * 8;
    unsigned char* ws = a.ws;
    float* rope = (float*)(ws + WS_ROPE); float* ssq = (float*)(ws + WS_SSQ);
    bf16_t* Win = (bf16_t*)(ws + WS_WIN); bf16_t* Wout = (bf16_t*)(ws + WS_WOUT); bf16_t* Wup = (bf16_t*)(ws + WS_WUP); bf16_t* Wdn = (bf16_t*)(ws + WS_WDN);
    bf16_t* XB = (bf16_t*)(ws + WS_XB); bf16_t* QKV = (bf16_t*)(ws + WS_QKV); bf16_t* HB = (bf16_t*)(ws + WS_H);
    float* out = a.out;

    {
        LAS float* scr = (LAS float*)(lds + wave * 16384);
        constexpr int I_IN = (D / 64) * (NIN / 32), I_OUT = (D / 64) * (D / 32), I_UP = (D / 64) * (FF / 32), I_DN = (FF / 64) * (D / 32);
        constexpr int I_LAYER = I_IN + I_OUT + I_UP + I_DN;
        for (int it = gw; it < DEPTH * I_LAYER; it += NGW) {
            const int l = it / I_LAYER; int r = it % I_LAYER;
            if (r < I_IN) { transpose_item(a.w_in + (size_t)l * D * NIN, D, NIN, Win + (size_t)l * NIN * D, a.norm_mix + l * D, true, scr, r, lane); continue; } r -= I_IN;
            if (r < I_OUT) { transpose_item(a.w_out + (size_t)l * D * D, D, D, Wout + (size_t)l * D * D, nullptr, false, scr, r, lane); continue; } r -= I_OUT;
            if (r < I_UP) { transpose_item(a.w_up + (size_t)l * D * FF, D, FF, Wup + (size_t)l * FF * D, a.norm_mlp + l * D, false, scr, r, lane); continue; } r -= I_UP;
            transpose_item(a.w_down + (size_t)l * FF * D, FF, D, Wdn + (size_t)l * D * FF, nullptr, false, scr, r, lane);
        }
        for (int row = gw; row < M_TOT; row += NGW) {
            const float* xr = (row < M_SPLIT ? a.xp + (size_t)row * D : a.xs + (size_t)(row - M_SPLIT) * D);
            float s = 0.f;
#pragma unroll
            for (int j = 0; j < 4; ++j) { const f32x4 v = *(const f32x4*)(xr + 4 * lane + 256 * j); s += (v.x * v.x + v.y * v.y) + (v.z * v.z + v.w * v.w);
                u32x2 wv; wv.x = cvtpk(v.x, v.y); wv.y = cvtpk(v.z, v.w); *(u32x2*)(XB + (size_t)row * D + 4 * lane + 256 * j) = wv; }
            s = wave_sum(s);
            if (lane < 16) ssq[(size_t)row * 16 + lane] = (lane == 0) ? s : 0.f;
        }
        for (int e = bx * 512 + tid; e < 16384 * 32; e += G * 512) {
            const int pos = e >> 5, i = e & 31; float co, si; sincos_acc((float)pos * a.inv_freq[i], co, si);
            rope[2 * e] = co; rope[2 * e + 1] = si;
        }
    }
    grid.sync();

    for (int l = 0; l < DEPTH; ++l) {
        {
            pg8::Gemm g{XB, Win + (size_t)l * NIN * D, M_TOT, NIN, D, D, D}; pg8::StaticOrder S; S.init(M_TOT, NIN, G, bx);
            EpiQKV E{QKV, ssq, (const f32x4*)rope};
#ifndef NO_G1
            pg8::gemm_phase<EpiQKV>(lds, g, S, E);
#endif
        }
        grid.sync();
        {
            const float* rpb_l = a.rpb + (size_t)l * 8 * 465; const float* sink_l = a.sink + l * 8;
            for (int i = bx; i < 9216; i += G) {
                const int k3 = i / 3, r3 = i % 3;
#ifndef NO_NA
                if (r3 < 2) { const int u = 2 * k3 + r3; na_unit(lds, QKV, rpb_l, u / 768, u % 768); }
#endif
#ifndef NO_SWA
                if (r3 == 2) { swa_unit(lds, QKV, sink_l, k3 / 1536, k3 % 1536); }
#endif
            }
        }
        grid.sync();
        {
            pg8::Gemm g{QKV, Wout + (size_t)l * D * D, M_TOT, D, D, NIN, D}; pg8::StaticOrder S; S.init(M_TOT, D, G, bx);
            EpiRes E{l == 0 ? a.xp : out, l == 0 ? a.xs : out + (size_t)M_SPLIT * D, out, XB, ssq, 0};
#ifndef NO_G2
            pg8::gemm_phase<EpiRes>(lds, g, S, E);
#endif
        }
        grid.sync();
        for (int c = 0; c < NCHUNK; ++c) {
            const int row0 = c * CHUNK_ROWS;
            {
                pg8::Gemm g{XB + (size_t)row0 * D, Wup + (size_t)l * FF * D, CHUNK_ROWS, FF, D, D, D}; pg8::StaticOrder S; S.init(CHUNK_ROWS, FF, G, bx);
                EpiUp E{HB, ssq, row0};
#ifndef NO_G3
                pg8::gemm_phase<EpiUp>(lds, g, S, E);
#endif
            }
            grid.sync();
            {
                pg8::Gemm g{HB, Wdn + (size_t)l * D * FF, CHUNK_ROWS, D, FF, FF, FF}; pg8::StaticOrder S; S.init(CHUNK_ROWS, D, G, bx);
                EpiRes E{out, out + (size_t)M_SPLIT * D, out, XB, ssq, row0};
#ifndef NO_G4
                pg8::gemm_phase<EpiRes>(lds, g, S, E);
#endif
            }
            grid.sync();
        }
    }
    for (int row = gw; row < M_TOT; row += NGW) {
        float s = (lane < 16) ? ssq[(size_t)row * 16 + lane] : 0.f;
        s = wave_sum(s);
        const float rs = rsqrtf(s * (1.0f / D) + EPS);
        float* xr = out + (size_t)row * D;
#pragma unroll
        for (int j = 0; j < 4; ++j) { const f32x4 v = *(const f32x4*)(xr + 4 * lane + 256 * j); const f32x4 gv = *(const f32x4*)(a.norm_final + 4 * lane + 256 * j);
            *(f32x4*)(xr + 4 * lane + 256 * j) = v * rs * gv; }
    }
}

extern "C" void kernel_launch(void* const* d_in, const int* in_sizes, int n_in, void* d_out, int out_size, void* d_ws, size_t ws_size, hipStream_t stream) {
    static int grid = 0;
    if (grid == 0) {
        if (n_in != 11 || out_size != M_TOT * D || ws_size < WS_END) { fprintf(stderr, "kernel_launch: unexpected shapes (n_in %d out %d ws %zu)\n", n_in, out_size, ws_size); grid = -1; return; }
        int dev = 0, cus = 0, per_cu = 0;
        hipGetDevice(&dev);
        hipDeviceGetAttribute(&cus, hipDeviceAttributeMultiprocessorCount, dev);
        hipFuncSetAttribute((const void*)mega_fwd, hipFuncAttributeMaxDynamicSharedMemorySize, LDS_BYTES);
        hipOccupancyMaxActiveBlocksPerMultiprocessor(&per_cu, (const void*)mega_fwd, 512, LDS_BYTES);
        if (per_cu < 1) { fprintf(stderr, "kernel_launch: occupancy query says %d blocks per CU\n", per_cu); per_cu = 1; }
        (void)hipGetLastError();
        grid = cus * 1;
    }
    if (grid < 0) return;
    Args a{};
    a.xp = (const float*)d_in[0]; a.xs = (const float*)d_in[1]; a.norm_mix = (const float*)d_in[2]; a.w_in = (const float*)d_in[3]; a.rpb = (const float*)d_in[4];
    a.sink = (const float*)d_in[5]; a.w_out = (const float*)d_in[6]; a.norm_mlp = (const float*)d_in[7]; a.w_up = (const float*)d_in[8]; a.w_down = (const float*)d_in[9];
    a.norm_final = (const float*)d_in[10]; a.out = (float*)d_out; a.ws = (unsigned char*)d_ws;
    for (int i = 0; i < 32; ++i) a.inv_freq[i] = (float)pow(10000.0, -(double)i / 32.0);
    void* args[] = {&a};
    hipError_t e = hipLaunchCooperativeKernel((const void*)mega_fwd, dim3(grid), dim3(512), args, LDS_BYTES, stream);
    if (e != hipSuccess) fprintf(stderr, "kernel_launch: cooperative launch failed: %s (grid %d)\n", hipGetErrorString(e), grid);
}
```

```cpp
#include <hip/hip_runtime.h>
#include <hip/hip_cooperative_groups.h>
#include <cstdio>
#include <cstdint>
#include <cmath>
namespace cg = cooperative_groups;

#define LAS __attribute__((address_space(3)))
typedef unsigned short bf16_t;
typedef short bf16x8 __attribute__((ext_vector_type(8)));
typedef short s16x4 __attribute__((ext_vector_type(4)));
typedef float f32x4 __attribute__((ext_vector_type(4)));
typedef float f32x2 __attribute__((ext_vector_type(2)));
typedef unsigned u32x4 __attribute__((ext_vector_type(4)));
typedef unsigned u32x2 __attribute__((ext_vector_type(2)));
typedef __bf16 bf16x2_t __attribute__((ext_vector_type(2)));

constexpr int D = 1024, DEPTH = 4, NIN = 2304, FF = 4096;
constexpr int M_TOT = 49152, M_SPLIT = 16384;
constexpr int NCHUNK = 3, CHUNK_ROWS = M_TOT / NCHUNK;
constexpr float EPS = 1e-5f;
constexpr float LOG2E = 1.4426950408889634f;
constexpr float QSCALE = 0.125f * LOG2E;
constexpr int C_QA = 0, C_QS = 512, C_KA = 1024, C_VA = 1536, C_KS = 2048, C_VS = 2176;

constexpr size_t MiB = 1u << 20;
constexpr size_t WS_ROPE = 1 * MiB;
constexpr size_t WS_SSQ = 5 * MiB;
constexpr size_t WS_WIN = 8 * MiB;
constexpr size_t WS_WOUT = 26 * MiB;
constexpr size_t WS_WUP = 34 * MiB;
constexpr size_t WS_WDN = 66 * MiB;
constexpr size_t WS_XB = 98 * MiB;
constexpr size_t WS_QKV = 194 * MiB;
constexpr size_t WS_H = 194 * MiB;
constexpr size_t WS_END = 410 * MiB;

constexpr int KROW = 144;
constexpr int LDS_KS = 0, LDS_VS = 512 * KROW, LDS_BIAS = 2 * 512 * KROW, LDS_XM = LDS_BIAS + 2048, LDS_TOTAL = LDS_XM + 1024;
constexpr int LDS_BST = LDS_TOTAL;
constexpr int LDS_BYTES = 151552;

__device__ __forceinline__ unsigned cvtpk(float lo, float hi) { f32x2 v = {lo, hi}; bf16x2_t b = __builtin_convertvector(v, bf16x2_t); return __builtin_bit_cast(unsigned, b); }
__device__ __forceinline__ float wave_sum(float v) {
#pragma unroll
    for (int o = 1; o < 64; o <<= 1) v += __shfl_xor(v, o);
    return v;
}

namespace pg8 {
constexpr int BM = 256, BK = 64, HALF = 128, HTB = HALF * BK * 2, STAGE_BYTES = 8 * HTB, NXCD = 8, WGM = 8;
__host__ __device__ __forceinline__ int lds_byte(int r, int c) { const int st = (r >> 4) * 2 + (c >> 5), rr = r & 15, cc = c & 31, ob = rr * 64 + cc * 2; return st * 1024 + (ob ^ (((ob >> 9) & 1) << 5)); }
__host__ __device__ __forceinline__ void stage_rc(int b, int& R, int& C) { const int st = b / 1024, sb = b % 1024, swz = sb ^ (((sb >> 9) & 1) << 5); R = (st >> 1) * 16 + swz / 64; C = (st & 1) * 32 + (swz % 64) / 2; }
__host__ __device__ __forceinline__ int perm32(int rho) { const int n = rho >> 4, i = rho & 15; return 8 * (i >> 2) + 4 * n + (i & 3); }

struct Unit { int pm, pn; };
struct Gemm { const bf16_t* A; const bf16_t* Bt; int M, N, K, lda, ldb; };

struct StaticOrder {
    int nM, nN, nwg, G, c;
    __device__ void init(int M, int N, int G_, int c_) { nM = M / BM; nN = N / BM; nwg = nM * nN; G = G_; c = c_; }
    __device__ bool next(int i, Unit& u) const {
        const long L = (long)i * G + c; if (L >= nwg) return false;
        int wgid = (int)L; { const int q = nwg / NXCD, r = nwg % NXCD, xcd = wgid % NXCD, off = wgid / NXCD; wgid = (xcd < r ? xcd * (q + 1) : r * (q + 1) + (xcd - r) * q) + off; }
        const int nig = WGM * nN, gid = wgid / nig, fm = gid * WGM, gsz = (nM - fm) < WGM ? (nM - fm) : WGM;
        u.pm = fm + ((wgid % nig) % gsz); u.pn = (wgid % nig) / gsz; return true;
    }
};

template <class Epi>
__device__ __forceinline__ void gemm_phase(LAS unsigned char* lds, const Gemm g, const StaticOrder& S, const Epi& E) {
    int tid = threadIdx.x; asm volatile("" : "+v"(tid));
    const int wid = __builtin_amdgcn_readfirstlane(tid >> 6), lane = tid & 63, wr = wid >> 2, wc = wid & 3, fr = lane & 15, fq = lane >> 4;
    const int K = g.K, nt = K / BK;
    unsigned voffA[2], voffB[2];
#pragma unroll
    for (int i = 0; i < 2; ++i) { int R, C; stage_rc(tid * 16 + i * 8192, R, C); const int Rb = Epi::PERM ? ((R & ~31) + perm32(R & 31)) : R;
        voffA[i] = (unsigned)(R * g.lda + C) * 2u; voffB[i] = (unsigned)(Rb * g.ldb + C) * 2u; }
    const size_t kstep = (size_t)(BK * 2);
    const size_t hstepA = (size_t)HALF * g.lda * 2, hstepB = (size_t)HALF * g.ldb * 2;
    const size_t tstepA = 2 * hstepA, tstepB = 2 * hstepB;
    const unsigned ldsw = (unsigned)wid * 1024u;
    const int aoff = lds_byte(wr * 64 + fr, fq * 8), boff = lds_byte(wc * 32 + fr, fq * 8);
#define PG8_SA(b, h) (((b) * 2 + (h)) * HTB)
#define PG8_SB(b, h) ((4 + (b) * 2 + (h)) * HTB)
#define PG8_STAGE(bufoff, gbase, voff) do { _Pragma("unroll") for (int _i = 0; _i < 2; ++_i) \
        __builtin_amdgcn_global_load_lds((const unsigned*)((const char*)(gbase) + (voff)[_i]), (LAS unsigned*)(lds + (bufoff) + ldsw + _i * 8192), 16, 0, 0); } while (0)
#define PG8_LDA(dst, b, h) do { _Pragma("unroll") for (int m = 0; m < 4; ++m) _Pragma("unroll") for (int k = 0; k < 2; ++k) dst[m][k] = *(const LAS bf16x8*)(lds + PG8_SA(b, h) + aoff + m * 2048 + k * 1024); } while (0)
#define PG8_LDB(dst, b, h) do { _Pragma("unroll") for (int n = 0; n < 2; ++n) _Pragma("unroll") for (int k = 0; k < 2; ++k) dst[n][k] = *(const LAS bf16x8*)(lds + PG8_SB(b, h) + boff + n * 2048 + k * 1024); } while (0)
#define PG8_MMA(ai, bj, At, Bt) do { __builtin_amdgcn_s_setprio(1); _Pragma("unroll") for (int m = 0; m < 4; ++m) _Pragma("unroll") for (int n = 0; n < 2; ++n) _Pragma("unroll") for (int k = 0; k < 2; ++k) \
        acc[ai][bj][m][n] = __builtin_amdgcn_mfma_f32_16x16x32_bf16(Bt[n][k], At[m][k], acc[ai][bj][m][n], 0, 0, 0); __builtin_amdgcn_s_setprio(0); } while (0)
#define PG8_WAIT_V(n) asm volatile("s_waitcnt vmcnt(" #n ")" ::: "memory")
#define PG8_WAIT_L(n) asm volatile("s_waitcnt lgkmcnt(" #n ")" ::: "memory")
#define PG8_BAR __builtin_amdgcn_s_barrier()
#define PG8_SCHED __builtin_amdgcn_sched_barrier(0)
    Unit cur, nxt; int ui = 0;
    if (!S.next(0, cur)) return;
    f32x4 acc[2][2][4][2];
#pragma unroll
    for (int a = 0; a < 2; ++a)
#pragma unroll
        for (int b = 0; b < 2; ++b)
#pragma unroll
            for (int m = 0; m < 4; ++m)
#pragma unroll
                for (int n = 0; n < 2; ++n) acc[a][b][m][n] = (f32x4){0.f, 0.f, 0.f, 0.f};
    bf16x8 At[4][2], B0[2][2], B1[2][2];
    const char* cA = (const char*)g.A + (size_t)cur.pm * tstepA; const char* cB = (const char*)g.Bt + (size_t)cur.pn * tstepB;
    PG8_STAGE(PG8_SB(0, 0), cB, voffB); PG8_STAGE(PG8_SB(0, 1), cB + hstepB, voffB); PG8_STAGE(PG8_SA(0, 0), cA, voffA); PG8_STAGE(PG8_SA(0, 1), cA + hstepA, voffA);
    if (wr == 1) PG8_BAR;
    PG8_WAIT_V(2); PG8_BAR;
    PG8_STAGE(PG8_SB(1, 0), cB + kstep, voffB); PG8_STAGE(PG8_SA(1, 0), cA + kstep, voffA); PG8_STAGE(PG8_SB(1, 1), cB + hstepB + kstep, voffB);
    PG8_WAIT_V(6); PG8_BAR;
    for (;;) {
        const bool has_next = S.next(ui + 1, nxt);
        const char* nA = has_next ? (const char*)g.A + (size_t)nxt.pm * tstepA : cA; const char* nB = has_next ? (const char*)g.Bt + (size_t)nxt.pn * tstepB : cB;
        for (int t = 0; t < nt; t += 2) {
            const bool last = (t == nt - 2);
            const char* a1 = cA + (size_t)(t + 1) * kstep;
            const char* a2 = last ? nA : cA + (size_t)(t + 2) * kstep; const char* b2 = last ? nB : cB + (size_t)(t + 2) * kstep;
            const char* a3 = a2 + kstep; const char* b3 = b2 + kstep;
            PG8_LDB(B0, 0, 0); PG8_LDB(B1, 0, 1); PG8_SCHED; PG8_LDA(At, 0, 0); PG8_STAGE(PG8_SA(1, 1), a1 + hstepA, voffA);
            PG8_WAIT_V(8); PG8_WAIT_L(0); PG8_BAR; PG8_MMA(0, 0, At, B0); PG8_MMA(0, 1, At, B1); PG8_BAR; PG8_SCHED;
            PG8_LDA(At, 0, 1); PG8_STAGE(PG8_SB(0, 0), b2, voffB); PG8_STAGE(PG8_SB(0, 1), b2 + hstepB, voffB); PG8_STAGE(PG8_SA(0, 0), a2, voffA);
            PG8_WAIT_V(8); PG8_WAIT_L(0); PG8_BAR; PG8_MMA(1, 0, At, B0); PG8_MMA(1, 1, At, B1); PG8_BAR; PG8_SCHED;
            PG8_LDB(B0, 1, 0); PG8_LDB(B1, 1, 1); PG8_SCHED; PG8_LDA(At, 1, 0); PG8_STAGE(PG8_SA(0, 1), a2 + hstepA, voffA);
            PG8_WAIT_V(8); PG8_WAIT_L(0); PG8_BAR; PG8_MMA(0, 0, At, B0); PG8_MMA(0, 1, At, B1); PG8_BAR; PG8_SCHED;
            PG8_LDA(At, 1, 1); PG8_STAGE(PG8_SB(1, 0), b3, voffB); PG8_STAGE(PG8_SB(1, 1), b3 + hstepB, voffB); PG8_STAGE(PG8_SA(1, 0), a3, voffA);
            PG8_WAIT_V(8); PG8_WAIT_L(0); PG8_BAR; PG8_MMA(1, 0, At, B0); PG8_MMA(1, 1, At, B1); PG8_BAR; PG8_SCHED;
        }
        if (wr == 0) PG8_BAR;
        E(acc, cur, wr, wc, fr, fq);
        if (!has_next) break;
#pragma unroll
        for (int a = 0; a < 2; ++a)
#pragma unroll
            for (int b = 0; b < 2; ++b)
#pragma unroll
                for (int m = 0; m < 4; ++m)
#pragma unroll
                    for (int n = 0; n < 2; ++n) acc[a][b][m][n] = (f32x4){0.f, 0.f, 0.f, 0.f};
        cur = nxt; cA = nA; cB = nB; ++ui;
        if (wr == 1) PG8_BAR;
    }
    PG8_WAIT_V(0);
    PG8_BAR;
#undef PG8_SA
#undef PG8_SB
#undef PG8_STAGE
#undef PG8_LDA
#undef PG8_LDB
#undef PG8_MMA
#undef PG8_WAIT_V
#undef PG8_WAIT_L
#undef PG8_BAR
#undef PG8_SCHED
}
}

__device__ __forceinline__ float row_rstd(const float* ssq, int row, int fq) {
    const f32x4 sp = *(const f32x4*)(ssq + (size_t)row * 16 + fq * 4);
    float s = (sp.x + sp.y) + (sp.z + sp.w);
    s += __shfl_xor(s, 16); s += __shfl_xor(s, 32);
    return rsqrtf(s * (1.0f / D) + EPS);
}
struct EpiQKV {
    static constexpr bool PERM = true;
    bf16_t* O; const float* ssq; const f32x4* rope;
    __device__ __forceinline__ void operator()(const f32x4 (&acc)[2][2][4][2], const pg8::Unit& u, int wr, int wc, int fr, int fq) const {
        const int pn = u.pn;
        const float qs = (pn < 4) ? QSCALE : 1.f;
        const int col0 = pn * 256 + wc * 32 + 8 * fq;
        const int i0h = 8 * (wc & 1) + 2 * fq;
#pragma unroll
        for (int ai = 0; ai < 2; ++ai)
#pragma unroll
            for (int m = 0; m < 4; ++m) {
                const int row = u.pm * 256 + ai * 128 + wr * 64 + m * 16 + fr;
                const float rs = row_rstd(ssq, row, fq) * qs;
                const int pos = row < M_SPLIT ? (row & 8191) : (row & 16383);
                bf16_t* rowp = O + (size_t)row * NIN + col0;
#pragma unroll
                for (int bj = 0; bj < 2; ++bj) {
                    f32x4 v0 = acc[ai][bj][m][0] * rs, v1 = acc[ai][bj][m][1] * rs;
                    const bool do_rope = (pn == 2) || (pn == 3) || (pn == 8 && bj == 0);
                    if (do_rope) {
                        const f32x4* rp = rope + (size_t)pos * 16 + i0h;
                        const f32x4 r0 = rp[0], r1 = rp[1];
                        v0 = (f32x4){v0.x * r0.x - v0.y * r0.y, v0.y * r0.x + v0.x * r0.y, v0.z * r0.z - v0.w * r0.w, v0.w * r0.z + v0.z * r0.w};
                        v1 = (f32x4){v1.x * r1.x - v1.y * r1.y, v1.y * r1.x + v1.x * r1.y, v1.z * r1.z - v1.w * r1.w, v1.w * r1.z + v1.z * r1.w};
                    }
                    u32x4 w; w.x = cvtpk(v0.x, v0.y); w.y = cvtpk(v0.z, v0.w); w.z = cvtpk(v1.x, v1.y); w.w = cvtpk(v1.z, v1.w);
                    *(u32x4*)(rowp + bj * 128) = w;
                }
            }
    }
};
struct EpiUp {
    static constexpr bool PERM = true;
    bf16_t* O; const float* ssq; int row0;
    __device__ __forceinline__ void operator()(const f32x4 (&acc)[2][2][4][2], const pg8::Unit& u, int wr, int wc, int fr, int fq) const {
        const int col0 = u.pn * 256 + wc * 32 + 8 * fq;
#pragma unroll
        for (int ai = 0; ai < 2; ++ai)
#pragma unroll
            for (int m = 0; m < 4; ++m) {
                const int rl = u.pm * 256 + ai * 128 + wr * 64 + m * 16 + fr;
                const float rs = row_rstd(ssq, row0 + rl, fq);
                bf16_t* rowp = O + (size_t)rl * FF + col0;
#pragma unroll
                for (int bj = 0; bj < 2; ++bj) {
                    f32x4 v0 = acc[ai][bj][m][0] * rs, v1 = acc[ai][bj][m][1] * rs;
                    v0 = __builtin_elementwise_max(v0, (f32x4){0.f, 0.f, 0.f, 0.f}); v1 = __builtin_elementwise_max(v1, (f32x4){0.f, 0.f, 0.f, 0.f});
                    v0 = v0 * v0; v1 = v1 * v1;
                    u32x4 w; w.x = cvtpk(v0.x, v0.y); w.y = cvtpk(v0.z, v0.w); w.z = cvtpk(v1.x, v1.y); w.w = cvtpk(v1.z, v1.w);
                    *(u32x4*)(rowp + bj * 128) = w;
                }
            }
    }
};
struct EpiRes {
    static constexpr bool PERM = false;
    const float* base0; const float* base1; float* out; bf16_t* xb; float* ssq; int row0;
    __device__ __forceinline__ void operator()(const f32x4 (&acc)[2][2][4][2], const pg8::Unit& u, int wr, int wc, int fr, int fq) const {
        const int col0 = u.pn * 256 + wc * 32 + 4 * fq;
#pragma unroll
        for (int ai = 0; ai < 2; ++ai)
#pragma unroll
            for (int m = 0; m < 4; ++m) {
                const int row = row0 + u.pm * 256 + ai * 128 + wr * 64 + m * 16 + fr;
                const float* bp = (row < M_SPLIT ? base0 + (size_t)row * D : base1 + (size_t)(row - M_SPLIT) * D) + col0;
                float* op = out + (size_t)row * D + col0; bf16_t* xp = xb + (size_t)row * D + col0;
                float s = 0.f;
#pragma unroll
                for (int bj = 0; bj < 2; ++bj)
#pragma unroll
                    for (int n = 0; n < 2; ++n) {
                        const f32x4 b = *(const f32x4*)(bp + bj * 128 + n * 16);
                        const f32x4 v = b + acc[ai][bj][m][n];
                        *(f32x4*)(op + bj * 128 + n * 16) = v;
                        s += (v.x * v.x + v.y * v.y) + (v.z * v.z + v.w * v.w);
                        u32x2 w; w.x = cvtpk(v.x, v.y); w.y = cvtpk(v.z, v.w);
                        *(u32x2*)(xp + bj * 128 + n * 16) = w;
                    }
                s += __shfl_xor(s, 16); s += __shfl_xor(s, 32);
                if (fq == 0) ssq[(size_t)row * 16 + u.pn * 4 + wc] = s;
            }
    }
};

__device__ __forceinline__ f32x4 mfma16(bf16x8 a, bf16x8 b, f32x4 c) { return __builtin_amdgcn_mfma_f32_16x16x32_bf16(a, b, c, 0, 0, 0); }
typedef short v4i16_t __attribute__((ext_vector_type(4)));
__device__ __forceinline__ s16x4 tr_read(LAS unsigned char* p) { return __builtin_bit_cast(s16x4, __builtin_amdgcn_ds_read_tr16_b64_v4i16((LAS v4i16_t*)p)); }
__device__ __forceinline__ bf16x8 pack_p(const f32x4& a, const f32x4& b) {
    u32x4 w; w.x = cvtpk(a.x, a.y); w.y = cvtpk(a.z, a.w); w.z = cvtpk(b.x, b.y); w.w = cvtpk(b.z, b.w); return __builtin_bit_cast(bf16x8, w);
}
__device__ __forceinline__ void pv_pair(f32x4 (&o)[4], LAS unsigned char* vaddr, bf16x8 pf) {
#pragma unroll
    for (int db = 0; db < 4; ++db) {
        const s16x4 a = tr_read(vaddr + db * 32), b = tr_read(vaddr + 16 * KROW + db * 32);
        const bf16x8 vf = (bf16x8){a[0], a[1], a[2], a[3], b[0], b[1], b[2], b[3]};
        o[db] = mfma16(vf, pf, o[db]);
    }
}

__device__ __forceinline__ void na_unit(LAS unsigned char* lds, bf16_t* QKV, const float* rpb_l, int h, int g) {
    int tid = threadIdx.x; asm volatile("" : "+v"(tid));
    const int lane = tid & 63, w = __builtin_amdgcn_readfirstlane(tid >> 6);
    const int glo = g < 128 ? 0 : (g < 256 ? 128 : (g < 512 ? 256 : 512));
    const int rows = g < 256 ? 128 : 256;
    int rs = g - 4; rs = rs < glo ? glo : rs; rs = rs > glo + rows - 8 ? glo + rows - 8 : rs;
    {
        const bf16_t* kb = QKV + (size_t)rs * 64 * NIN + C_KA + 64 * h;
        u32x4 kr[8], vr[8];
#pragma unroll
        for (int i = 0; i < 8; ++i) { const int idx = tid + 512 * i, kidx = idx >> 3, ch = idx & 7; const bf16_t* p = kb + (size_t)kidx * NIN + ch * 8;
            kr[i] = *(const u32x4*)p; vr[i] = *(const u32x4*)(p + (C_VA - C_KA)); }
#pragma unroll
        for (int i = 0; i < 8; ++i) { const int idx = tid + 512 * i, kidx = idx >> 3, ch = idx & 7;
            *(LAS u32x4*)(lds + LDS_KS + kidx * KROW + ch * 16) = kr[i]; *(LAS u32x4*)(lds + LDS_VS + kidx * KROW + ch * 16) = vr[i]; }
    }
    LAS float* bias = (LAS float*)(lds + LDS_BIAS);
    if (tid < 465) bias[tid] = rpb_l[h * 465 + tid] * LOG2E;
    const int jc = w & 3, half = w >> 2, n = lane & 15, q4 = lane >> 4;
    bf16_t* qp = QKV + ((size_t)g * 64 + 16 * jc + n) * NIN + C_QA + 64 * h;
    const bf16x8 qf0 = *(const bf16x8*)(qp + 8 * q4), qf1 = *(const bf16x8*)(qp + 32 + 8 * q4);
    __syncthreads();
    const int cb = jc == 0 ? 0 : (jc == 1 ? 8 : (jc == 2 ? 24 : 32));
    f32x4 s[4][2];
#pragma unroll
    for (int jr = 0; jr < 4; ++jr)
#pragma unroll
        for (int t = 0; t < 2; ++t) {
            const LAS unsigned char* kp = lds + LDS_KS + (64 * (4 * half + jr) + cb + 16 * t + n) * KROW + q4 * 16;
            const bf16x8 k0 = *(const LAS bf16x8*)kp, k1 = *(const LAS bf16x8*)(kp + 64);
            f32x4 z = (f32x4){0.f, 0.f, 0.f, 0.f};
            z = mfma16(k0, qf0, z); z = mfma16(k1, qf1, z);
            s[jr][t] = z;
        }
    const int c = 16 * jc + n; int cs = c - 8; cs = cs < 0 ? 0 : cs; cs = cs > 48 ? 48 : cs;
    float mx = -1e30f;
#pragma unroll
    for (int jr = 0; jr < 4; ++jr) {
        const int brow = (rs + 4 * half + jr - g + 7) * 31;
#pragma unroll
        for (int t = 0; t < 2; ++t)
#pragma unroll
            for (int i = 0; i < 4; ++i) {
                const int kc = cb + 16 * t + 4 * q4 + i;
                const bool valid = (kc >= cs) && (kc < cs + 16);
                const float bv = bias[valid ? brow + (kc - c + 15) : 0];
                const float v = valid ? s[jr][t][i] + bv : -1e30f;
                s[jr][t][i] = v; mx = fmaxf(mx, v);
            }
    }
    mx = fmaxf(mx, __shfl_xor(mx, 16)); mx = fmaxf(mx, __shfl_xor(mx, 32));
    LAS float* xm = (LAS float*)(lds + LDS_XM);
    if (q4 == 0) xm[w * 16 + n] = mx;
    __syncthreads();
    mx = fmaxf(mx, xm[(w ^ 4) * 16 + n]);
    float l = 0.f;
#pragma unroll
    for (int jr = 0; jr < 4; ++jr)
#pragma unroll
        for (int t = 0; t < 2; ++t)
#pragma unroll
            for (int i = 0; i < 4; ++i) { const float p = __builtin_amdgcn_exp2f(s[jr][t][i] - mx); s[jr][t][i] = p; l += p; }
    l += __shfl_xor(l, 16); l += __shfl_xor(l, 32);
    f32x4 o[4];
#pragma unroll
    for (int db = 0; db < 4; ++db) o[db] = (f32x4){0.f, 0.f, 0.f, 0.f};
#pragma unroll
    for (int jr = 0; jr < 4; ++jr) {
        LAS unsigned char* va = lds + LDS_VS + (64 * (4 * half + jr) + cb + 4 * q4 + (n >> 2)) * KROW + (n & 3) * 8;
        pv_pair(o, va, pack_p(s[jr][0], s[jr][1]));
    }
    LAS float* scr = (LAS float*)(lds + LDS_KS) + (w & 3) * (17 * 64);
    if (half == 1) {
#pragma unroll
        for (int db = 0; db < 4; ++db)
#pragma unroll
            for (int i = 0; i < 4; ++i) scr[(db * 4 + i) * 64 + lane] = o[db][i];
        scr[16 * 64 + lane] = l;
    }
    __syncthreads();
    if (half == 0) {
        l += scr[16 * 64 + lane];
        const float inv = 1.0f / l;
#pragma unroll
        for (int db = 0; db < 4; ++db) {
            f32x4 v = o[db];
#pragma unroll
            for (int i = 0; i < 4; ++i) v[i] = (v[i] + scr[(db * 4 + i) * 64 + lane]) * inv;
            u32x2 wv; wv.x = cvtpk(v.x, v.y); wv.y = cvtpk(v.z, v.w);
            *(u32x2*)(qp + 16 * db + 4 * q4) = wv;
        }
    }
    __syncthreads();
}

__device__ __forceinline__ void swa_unit(LAS unsigned char* lds, bf16_t* QKV, const float* sink_l, int kvh, int pb) {
    int tid = threadIdx.x; asm volatile("" : "+v"(tid));
    const int lane = tid & 63, w = __builtin_amdgcn_readfirstlane(tid >> 6);
    const int P0 = 32 * pb;
    const int slo = P0 < 8192 ? 0 : (P0 < 16384 ? 8192 : (P0 < 32768 ? 16384 : 32768));
    const int shi = P0 < 8192 ? 8192 : (P0 < 16384 ? 16384 : (P0 < 32768 ? 32768 : 49152));
    {
        u32x4 kr[5], vr[5];
#pragma unroll
        for (int i = 0; i < 5; ++i) { const int idx = tid + 512 * i, kidx = idx >> 3, ch = idx & 7; const int tok = P0 - 128 + kidx;
            const bool ok = (idx < 304 * 8) && tok >= slo && tok < shi;
            const bf16_t* p = QKV + (size_t)(ok ? tok : P0) * NIN + C_KS + 64 * kvh + ch * 8;
            const u32x4 z = (u32x4){0u, 0u, 0u, 0u};
            const u32x4 a = *(const u32x4*)p, b = *(const u32x4*)(p + (C_VS - C_KS));
            kr[i] = ok ? a : z; vr[i] = ok ? b : z; }
#pragma unroll
        for (int i = 0; i < 5; ++i) { const int idx = tid + 512 * i, kidx = idx >> 3, ch = idx & 7;
            if (idx < 304 * 8) { *(LAS u32x4*)(lds + LDS_KS + kidx * KROW + ch * 16) = kr[i]; *(LAS u32x4*)(lds + LDS_VS + kidx * KROW + ch * 16) = vr[i]; } }
    }
    const int hq = 4 * kvh + (w & 3), pg = w >> 2, n = lane & 15, q4 = lane >> 4;
    const int p0 = P0 + 16 * pg;
    bf16_t* qp = QKV + (size_t)(p0 + n) * NIN + C_QS + 64 * hq;
    const bf16x8 qf0 = *(const bf16x8*)(qp + 8 * q4), qf1 = *(const bf16x8*)(qp + 32 + 8 * q4);
    const float sinkv = sink_l[hq] * LOG2E;
    __syncthreads();
    f32x4 s[9][2];
#pragma unroll
    for (int j = 0; j < 9; ++j)
#pragma unroll
        for (int t = 0; t < 2; ++t) {
            const LAS unsigned char* kp = lds + LDS_KS + (16 * pg + 32 * j + 16 * t + n) * KROW + q4 * 16;
            const bf16x8 k0 = *(const LAS bf16x8*)kp, k1 = *(const LAS bf16x8*)(kp + 64);
            f32x4 z = (f32x4){0.f, 0.f, 0.f, 0.f};
            z = mfma16(k0, qf0, z); z = mfma16(k1, qf1, z);
            s[j][t] = z;
        }
    float mx = -1e30f;
#pragma unroll
    for (int j = 0; j < 9; ++j)
#pragma unroll
        for (int t = 0; t < 2; ++t)
#pragma unroll
            for (int i = 0; i < 4; ++i) {
                const int dl = 32 * j + 16 * t + 4 * q4 + i - 128 - n;
                const int key = p0 + n + dl;
                const bool valid = (dl >= -128) && (dl <= 128) && (key >= slo) && (key < shi);
                const float v = valid ? s[j][t][i] : -1e30f;
                s[j][t][i] = v; mx = fmaxf(mx, v);
            }
    mx = fmaxf(mx, __shfl_xor(mx, 16)); mx = fmaxf(mx, __shfl_xor(mx, 32));
    mx = fmaxf(mx, sinkv);
    float l = 0.f;
#pragma unroll
    for (int j = 0; j < 9; ++j)
#pragma unroll
        for (int t = 0; t < 2; ++t)
#pragma unroll
            for (int i = 0; i < 4; ++i) { const float p = __builtin_amdgcn_exp2f(s[j][t][i] - mx); s[j][t][i] = p; l += p; }
    l += __shfl_xor(l, 16); l += __shfl_xor(l, 32);
    l += __builtin_amdgcn_exp2f(sinkv - mx);
    f32x4 o[4];
#pragma unroll
    for (int db = 0; db < 4; ++db) o[db] = (f32x4){0.f, 0.f, 0.f, 0.f};
#pragma unroll
    for (int j = 0; j < 9; ++j) {
        LAS unsigned char* va = lds + LDS_VS + (16 * pg + 32 * j + 4 * q4 + (n >> 2)) * KROW + (n & 3) * 8;
        pv_pair(o, va, pack_p(s[j][0], s[j][1]));
    }
    const float inv = 1.0f / l;
#pragma unroll
    for (int db = 0; db < 4; ++db) {
        const f32x4 v = o[db] * inv;
        u32x2 wv; wv.x = cvtpk(v.x, v.y); wv.y = cvtpk(v.z, v.w);
        *(u32x2*)(qp + 16 * db + 4 * q4) = wv;
    }
    __syncthreads();
}

__device__ __forceinline__ int win_src(int n) {
    if (n < 512) return n;
    if (n < 1024) { const int p = n - 512, pp = p & 63; return 1536 + (p & ~63) + (pp >> 1) + ((pp & 1) << 5); }
    if (n < 1536) return 512 + (n - 1024);
    if (n < 2048) return 1024 + (n - 1536);
    if (n < 2176) { const int p = n - 2048, pp = p & 63; return 2048 + (p & ~63) + (pp >> 1) + ((pp & 1) << 5); }
    return n;
}
__device__ __forceinline__ void transpose_item(const float* W, int K, int N, bf16_t* WT, const float* gain, bool inmap, LAS float* scr, int item, int lane) {
    const int nblk = N / 32, kb = item / nblk, nb = item % nblk, k0 = 64 * kb, n0 = 32 * nb;
    const int nphys = n0 + (lane & 31), src = inmap ? win_src(nphys) : nphys;
#pragma unroll 8
    for (int i = 0; i < 32; ++i) { const int kk = 2 * i + (lane >> 5); const float gv = gain ? gain[k0 + kk] : 1.f; scr[kk * 33 + (lane & 31)] = W[(size_t)(k0 + kk) * N + src] * gv; }
    asm volatile("s_waitcnt lgkmcnt(0)" ::: "memory");
    const int c = lane & 7;
#pragma unroll
    for (int j = 0; j < 4; ++j) { const int n = (lane >> 3) + 8 * j; const LAS float* s = scr + (8 * c) * 33 + n;
        u32x4 o; o.x = cvtpk(s[0 * 33], s[1 * 33]); o.y = cvtpk(s[2 * 33], s[3 * 33]); o.z = cvtpk(s[4 * 33], s[5 * 33]); o.w = cvtpk(s[6 * 33], s[7 * 33]);
        *(u32x4*)(WT + (size_t)(n0 + n) * K + k0 + 8 * c) = o; }
    asm volatile("s_waitcnt lgkmcnt(0)" ::: "memory");
}
__device__ __forceinline__ void sincos_acc(float ang, float& co, float& si) {
    const double a = (double)ang;
    const double q = __builtin_rint(a * 0.63661977236758134308);
    double r = __builtin_fma(-q, 1.57079632679489655800e+00, a); r = __builtin_fma(-q, 6.12323399573676603587e-17, r);
    const double r2 = r * r;
    double sp = -2.50521083854417187751e-08; sp = sp * r2 + 2.75573192239858906526e-06; sp = sp * r2 - 1.98412698412698412698e-04; sp = sp * r2 + 8.33333333333333333333e-03; sp = sp * r2 - 1.66666666666666666667e-01;
    const double sn = r + r * r2 * sp;
    double cp = 2.08767569878680989792e-09; cp = cp * r2 - 2.75573192239858906526e-07; cp = cp * r2 + 2.48015873015873015873e-05; cp = cp * r2 - 1.38888888888888888889e-03; cp = cp * r2 + 4.16666666666666666667e-02; cp = cp * r2 - 0.5;
    const double cn = 1.0 + r2 * cp;
    const int qi = ((int)q) & 3;
    const double c2 = (qi == 0) ? cn : (qi == 1) ? -sn : (qi == 2) ? -cn : sn;
    const double s2 = (qi == 0) ? sn : (qi == 1) ? cn : (qi == 2) ? -sn : -cn;
    co = (float)c2; si = (float)s2;
}

#define XB_TMO      128
#define XB_XCNT(j)  (256  + 64 * (j))
#define XB_XSUB(j)  (1280 + 64 * (j))
#define XB_XGEN(j)  (2304 + 64 * (j))
#define XB_TOP      3328
#define XB_TOPGEN   3392
#define XCD_BAR_WORDS 3456
#define XB_SPIN_CAP (1u << 18)
__device__ __forceinline__ unsigned xb_ld(unsigned* p)              { return __hip_atomic_load(p, __ATOMIC_RELAXED, __HIP_MEMORY_SCOPE_AGENT); }
__device__ __forceinline__ unsigned xb_add(unsigned* p, unsigned v) { return __hip_atomic_fetch_add(p, v, __ATOMIC_RELAXED, __HIP_MEMORY_SCOPE_AGENT); }
__device__ __forceinline__ unsigned xb_xcc_id() { return (unsigned)__builtin_amdgcn_s_getreg((3 << 11) | 20) & 0xFu; }
#define XB_SPIN(cond, bar) do { unsigned _sp = 0; while (cond) { __builtin_amdgcn_s_sleep(1); \
    if ((++_sp & 255u) == 0u) { if (xb_ld(&(bar)[XB_TMO])) break; if (_sp > XB_SPIN_CAP) { atomicAdd(&(bar)[XB_TMO], 1u); break; } } } } while (0)
struct XcdBarrier { unsigned* bar; unsigned x; volatile LAS unsigned* st; };
__device__ __forceinline__ XcdBarrier xcd_barrier_post(unsigned* bar, volatile LAS unsigned* st) {
    XcdBarrier b; b.bar = bar; b.x = xb_xcc_id(); b.st = st;
    if (threadIdx.x == 0) (void)xb_add(&bar[XB_XCNT(b.x)], 1u);
    return b;
}
__device__ __forceinline__ void xcd_barrier_complete(unsigned* bar, unsigned x, unsigned& nloc, unsigned& nx) {
    const unsigned G = gridDim.x * gridDim.y * gridDim.z;
    unsigned sum, cnt, mine, sp = 0u;
    for (;;) {
        sum = 0u; cnt = 0u; mine = 0u;
#pragma unroll
        for (unsigned j = 0; j < 16; ++j) { const unsigned c = xb_ld(&bar[XB_XCNT(j)]); sum += c; cnt += (c > 0u) ? 1u : 0u; mine = (j == x) ? c : mine; }
        if (sum == G) break;
        __builtin_amdgcn_s_sleep(1);
        if ((++sp & 255u) == 0u) { if (xb_ld(&bar[XB_TMO])) break; if (sp > XB_SPIN_CAP) { atomicAdd(&bar[XB_TMO], 1u); break; } }
    }
    nloc = mine > 0u ? mine : 1u; nx = cnt > 0u ? cnt : 1u;
}
__device__ __forceinline__ void xcd_barrier(const XcdBarrier& b) {
    asm volatile("s_waitcnt vmcnt(0)" ::: "memory");
    __syncthreads();
    if (threadIdx.x == 0) {
        unsigned* bar = b.bar;
        __builtin_amdgcn_s_waitcnt(0);
        unsigned nloc = b.st[0], nx = b.st[1];
        if (nloc == 0u) { xcd_barrier_complete(bar, b.x, nloc, nx); b.st[0] = nloc; b.st[1] = nx; }
        const unsigned old = xb_add(&bar[XB_XSUB(b.x)], 1u);
        const unsigned gen = old / nloc;
        if (old + 1u == (gen + 1u) * nloc) {
            __builtin_amdgcn_fence(__ATOMIC_RELEASE, "agent");
            asm volatile("s_waitcnt vmcnt(0)" ::: "memory");
            const unsigned og = xb_add(&bar[XB_TOP], 1u);
            const unsigned tg = og / nx;
            if (og + 1u == (tg + 1u) * nx) xb_add(&bar[XB_TOPGEN], 1u);
            else XB_SPIN(xb_ld(&bar[XB_TOPGEN]) == tg, bar);
            __builtin_amdgcn_fence(__ATOMIC_ACQUIRE, "agent");
            xb_add(&bar[XB_XGEN(b.x)], 1u);
            asm volatile("s_waitcnt vmcnt(0)" ::: "memory");
        } else {
            XB_SPIN(xb_ld(&bar[XB_XGEN(b.x)]) == gen, bar);
            __builtin_amdgcn_fence(__ATOMIC_ACQUIRE, "agent");
            asm volatile("s_waitcnt vmcnt(0)" ::: "memory");
        }
    }
    __syncthreads();
}

struct Args {
    const float* xp; const float* xs; const float* norm_mix; const float* w_in; const float* rpb; const float* sink; const float* w_out;
    const float* norm_mlp; const float* w_up; const float* w_down; const float* norm_final;
    float* out; unsigned char* ws;
    float inv_freq[32];
};

__global__ void __launch_bounds__(512, 2) mega_fwd(Args a) {
    extern __shared__ __attribute__((aligned(16))) unsigned char lds_raw[];
    LAS unsigned char* lds = (LAS unsigned char*)lds_raw;
    cg::grid_group grid = cg::this_grid();
    const int tid = threadIdx.x, lane = tid & 63, wave = __builtin_amdgcn_readfirstlane(tid >> 6);
    const int G = gridDim.x, bx = blockIdx.x;
    const int gw = bx * 8 + wave, NGW = G * 8;
    unsigned char* ws = a.ws;
    float* rope = (float*)(ws + WS_ROPE); float* ssq = (float*)(ws + WS_SSQ);
    bf16_t* Win = (bf16_t*)(ws + WS_WIN); bf16_t* Wout = (bf16_t*)(ws + WS_WOUT); bf16_t* Wup = (bf16_t*)(ws + WS_WUP); bf16_t* Wdn = (bf16_t*)(ws + WS_WDN);
    bf16_t* XB = (bf16_t*)(ws + WS_XB); bf16_t* QKV = (bf16_t*)(ws + WS_QKV); bf16_t* HB = (bf16_t*)(ws + WS_H);
    float* out = a.out;
    unsigned* barw = (unsigned*)ws;
    if (bx == 0) for (int i = tid; i < XCD_BAR_WORDS; i += 512) barw[i] = 0u;
    volatile LAS unsigned* bst = (volatile LAS unsigned*)(lds + LDS_BST);
    if (tid < 4) bst[tid] = 0u;

    {
        LAS float* scr = (LAS float*)(lds + wave * 16384);
        constexpr int I_IN = (D / 64) * (NIN / 32), I_OUT = (D / 64) * (D / 32), I_UP = (D / 64) * (FF / 32), I_DN = (FF / 64) * (D / 32);
        constexpr int I_LAYER = I_IN + I_OUT + I_UP + I_DN;
        for (int it = gw; it < DEPTH * I_LAYER; it += NGW) {
            const int l = it / I_LAYER; int r = it % I_LAYER;
            if (r < I_IN) { transpose_item(a.w_in + (size_t)l * D * NIN, D, NIN, Win + (size_t)l * NIN * D, a.norm_mix + l * D, true, scr, r, lane); continue; } r -= I_IN;
            if (r < I_OUT) { transpose_item(a.w_out + (size_t)l * D * D, D, D, Wout + (size_t)l * D * D, nullptr, false, scr, r, lane); continue; } r -= I_OUT;
            if (r < I_UP) { transpose_item(a.w_up + (size_t)l * D * FF, D, FF, Wup + (size_t)l * FF * D, a.norm_mlp + l * D, false, scr, r, lane); continue; } r -= I_UP;
            transpose_item(a.w_down + (size_t)l * FF * D, FF, D, Wdn + (size_t)l * D * FF, nullptr, false, scr, r, lane);
        }
        for (int row = gw; row < M_TOT; row += NGW) {
            const float* xr = (row < M_SPLIT ? a.xp + (size_t)row * D : a.xs + (size_t)(row - M_SPLIT) * D);
            float s = 0.f;
#pragma unroll
            for (int j = 0; j < 4; ++j) { const f32x4 v = *(const f32x4*)(xr + 4 * lane + 256 * j); s += (v.x * v.x + v.y * v.y) + (v.z * v.z + v.w * v.w);
                u32x2 wv; wv.x = cvtpk(v.x, v.y); wv.y = cvtpk(v.z, v.w); *(u32x2*)(XB + (size_t)row * D + 4 * lane + 256 * j) = wv; }
            s = wave_sum(s);
            if (lane < 16) ssq[(size_t)row * 16 + lane] = (lane == 0) ? s : 0.f;
        }
        for (int e = bx * 512 + tid; e < 16384 * 32; e += G * 512) {
            const int pos = e >> 5, i = e & 31; float co, si; sincos_acc((float)pos * a.inv_freq[i], co, si);
            rope[2 * e] = co; rope[2 * e + 1] = si;
        }
    }
    grid.sync();
    const XcdBarrier xbar = xcd_barrier_post(barw, bst);

    for (int l = 0; l < DEPTH; ++l) {
        {
            pg8::Gemm g{XB, Win + (size_t)l * NIN * D, M_TOT, NIN, D, D, D}; pg8::StaticOrder S; S.init(M_TOT, NIN, G, bx);
            EpiQKV E{QKV, ssq, (const f32x4*)rope};
#ifndef NO_G1
            pg8::gemm_phase<EpiQKV>(lds, g, S, E);
#endif
        }
        xcd_barrier(xbar);
        {
            const float* rpb_l = a.rpb + (size_t)l * 8 * 465; const float* sink_l = a.sink + l * 8;
            for (int i = bx; i < 9216; i += G) {
                const int k3 = i / 3, r3 = i % 3;
#ifndef NO_NA
                if (r3 < 2) { const int u = 2 * k3 + r3; na_unit(lds, QKV, rpb_l, u / 768, u % 768); }
#endif
#ifndef NO_SWA
                if (r3 == 2) { swa_unit(lds, QKV, sink_l, k3 / 1536, k3 % 1536); }
#endif
            }
        }
        xcd_barrier(xbar);
        {
            pg8::Gemm g{QKV, Wout + (size_t)l * D * D, M_TOT, D, D, NIN, D}; pg8::StaticOrder S; S.init(M_TOT, D, G, bx);
            EpiRes E{l == 0 ? a.xp : out, l == 0 ? a.xs : out + (size_t)M_SPLIT * D, out, XB, ssq, 0};
#ifndef NO_G2
            pg8::gemm_phase<EpiRes>(lds, g, S, E);
#endif
        }
        xcd_barrier(xbar);
        for (int c = 0; c < NCHUNK; ++c) {
            const int row0 = c * CHUNK_ROWS;
            {
                pg8::Gemm g{XB + (size_t)row0 * D, Wup + (size_t)l * FF * D, CHUNK_ROWS, FF, D, D, D}; pg8::StaticOrder S; S.init(CHUNK_ROWS, FF, G, bx);
                EpiUp E{HB, ssq, row0};
#ifndef NO_G3
                pg8::gemm_phase<EpiUp>(lds, g, S, E);
#endif
            }
            xcd_barrier(xbar);
            {
                pg8::Gemm g{HB, Wdn + (size_t)l * D * FF, CHUNK_ROWS, D, FF, FF, FF}; pg8::StaticOrder S; S.init(CHUNK_ROWS, D, G, bx);
                EpiRes E{out, out + (size_t)M_SPLIT * D, out, XB, ssq, row0};
#ifndef NO_G4
                pg8::gemm_phase<EpiRes>(lds, g, S, E);
#endif
            }
            xcd_barrier(xbar);
        }
    }
    for (int row = gw; row < M_TOT; row += NGW) {
        float s = (lane < 16) ? ssq[(size_t)row * 16 + lane] : 0.f;
        s = wave_sum(s);
        const float rs = rsqrtf(s * (1.0f / D) + EPS);
        float* xr = out + (size_t)row * D;
#pragma unroll
        for (int j = 0; j < 4; ++j) { const f32x4 v = *(const f32x4*)(xr + 4 * lane + 256 * j); const f32x4 gv = *(const f32x4*)(a.norm_final + 4 * lane + 256 * j);
            *(f32x4*)(xr + 4 * lane + 256 * j) = v * rs * gv; }
    }
}

extern "C" void kernel_launch(void* const* d_in, const int* in_sizes, int n_in, void* d_out, int out_size, void* d_ws, size_t ws_size, hipStream_t stream) {
    static int grid = 0;
    if (grid == 0) {
        if (n_in != 11 || out_size != M_TOT * D || ws_size < WS_END) { fprintf(stderr, "kernel_launch: unexpected shapes (n_in %d out %d ws %zu)\n", n_in, out_size, ws_size); grid = -1; return; }
        int dev = 0, cus = 0, per_cu = 0;
        hipGetDevice(&dev);
        hipDeviceGetAttribute(&cus, hipDeviceAttributeMultiprocessorCount, dev);
        hipFuncSetAttribute((const void*)mega_fwd, hipFuncAttributeMaxDynamicSharedMemorySize, LDS_BYTES);
        hipOccupancyMaxActiveBlocksPerMultiprocessor(&per_cu, (const void*)mega_fwd, 512, LDS_BYTES);
        if (per_cu < 1) { fprintf(stderr, "kernel_launch: occupancy query says %d blocks per CU\n", per_cu); per_cu = 1; }
        (void)hipGetLastError();
        grid = cus * 1;
    }
    if (grid < 0) return;
    Args a{};
    a.xp = (const float*)d_in[0]; a.xs = (const float*)d_in[1]; a.norm_mix = (const float*)d_in[2]; a.w_in = (const float*)d_in[3]; a.rpb = (const float*)d_in[4];
    a.sink = (const float*)d_in[5]; a.w_out = (const float*)d_in[6]; a.norm_mlp = (const float*)d_in[7]; a.w_up = (const float*)d_in[8]; a.w_down = (const float*)d_in[9];
    a.norm_final = (const float*)d_in[10]; a.out = (float*)d_out; a.ws = (unsigned char*)d_ws;
    for (int i = 0; i < 32; ++i) a.inv_freq[i] = (float)pow(10000.0, -(double)i / 32.0);
    void* args[] = {&a};
    hipError_t e = hipLaunchCooperativeKernel((const void*)mega_fwd, dim3(grid), dim3(512), args, LDS_BYTES, stream);
    if (e != hipSuccess) fprintf(stderr, "kernel_launch: cooperative launch failed: %s (grid %d)\n", hipGetErrorString(e), grid);
}
```

```cpp
#include <hip/hip_runtime.h>
#include <hip/hip_cooperative_groups.h>
#include <cstdio>
#include <cstdint>
#include <cmath>
namespace cg = cooperative_groups;

#define LAS __attribute__((address_space(3)))
typedef unsigned short bf16_t;
typedef short bf16x8 __attribute__((ext_vector_type(8)));
typedef short s16x4 __attribute__((ext_vector_type(4)));
typedef float f32x4 __attribute__((ext_vector_type(4)));
typedef float f32x2 __attribute__((ext_vector_type(2)));
typedef unsigned u32x4 __attribute__((ext_vector_type(4)));
typedef unsigned u32x2 __attribute__((ext_vector_type(2)));
typedef __bf16 bf16x2_t __attribute__((ext_vector_type(2)));

constexpr int D = 1024, DEPTH = 4, NIN = 2304, FF = 4096;
constexpr int M_TOT = 49152, M_SPLIT = 16384;
constexpr int NCHUNK = 2, CHUNK_ROWS = M_TOT / NCHUNK;
constexpr float EPS = 1e-5f;
constexpr float LOG2E = 1.4426950408889634f;
constexpr float QSCALE = 0.125f * LOG2E;
constexpr int C_QA = 0, C_QS = 512, C_KA = 1024, C_VA = 1536, C_KS = 2048, C_VS = 2176;
constexpr int G_QA = 0, G_QS = 8, G_KA = 16, G_VA = 24, G_KS = 32, G_VS = 34;
constexpr size_t GSTRIDE = (size_t)49152 * 64;

constexpr size_t MiB = 1u << 20;
constexpr size_t WS_ROPE = 1 * MiB;
constexpr size_t WS_SSQ = 5 * MiB;
constexpr size_t WS_WIN = 8 * MiB;
constexpr size_t WS_WOUT = 26 * MiB;
constexpr size_t WS_WUP = 34 * MiB;
constexpr size_t WS_WDN = 66 * MiB;
constexpr size_t WS_XB = 98 * MiB;
constexpr size_t WS_QKV = 194 * MiB;
constexpr size_t WS_H = 194 * MiB;
constexpr size_t WS_END = 410 * MiB;

constexpr int KROW = 144;
constexpr int LDS_KS = 0, LDS_VS = 512 * KROW, LDS_BIAS = 2 * 512 * KROW, LDS_XM = LDS_BIAS + 2048, LDS_TOTAL = LDS_XM + 1024;
constexpr int LDS_SSQ = 131072;
constexpr int LDS_BYTES = 163840;

__device__ __forceinline__ unsigned cvtpk(float lo, float hi) { f32x2 v = {lo, hi}; bf16x2_t b = __builtin_convertvector(v, bf16x2_t); return __builtin_bit_cast(unsigned, b); }
__device__ __forceinline__ float quad_sum(float s) {
    const auto a = __builtin_amdgcn_permlane16_swap(__float_as_uint(s), __float_as_uint(s), false, false);
    const float t = __uint_as_float(a[0]) + __uint_as_float(a[1]);
    const auto b = __builtin_amdgcn_permlane32_swap(__float_as_uint(t), __float_as_uint(t), false, false);
    return __uint_as_float(b[0]) + __uint_as_float(b[1]);
}
__device__ __forceinline__ float quad_max(float s) {
    const auto a = __builtin_amdgcn_permlane16_swap(__float_as_uint(s), __float_as_uint(s), false, false);
    const float t = fmaxf(__uint_as_float(a[0]), __uint_as_float(a[1]));
    const auto b = __builtin_amdgcn_permlane32_swap(__float_as_uint(t), __float_as_uint(t), false, false);
    return fmaxf(__uint_as_float(b[0]), __uint_as_float(b[1]));
}
__device__ __forceinline__ float wave_sum(float v) {
#pragma unroll
    for (int o = 1; o < 64; o <<= 1) v += __shfl_xor(v, o);
    return v;
}

namespace pg8 {
constexpr int BM = 256, BK = 64, HALF = 128, HTB = HALF * BK * 2, STAGE_BYTES = 8 * HTB, NXCD = 8, WGM = 8;
__host__ __device__ __forceinline__ int lds_byte(int r, int c) { const int st = (r >> 4) * 2 + (c >> 5), rr = r & 15, cc = c & 31, ob = rr * 64 + cc * 2; return st * 1024 + (ob ^ (((ob >> 9) & 1) << 5)); }
__host__ __device__ __forceinline__ void stage_rc(int b, int& R, int& C) { const int st = b / 1024, sb = b % 1024, swz = sb ^ (((sb >> 9) & 1) << 5); R = (st >> 1) * 16 + swz / 64; C = (st & 1) * 32 + (swz % 64) / 2; }
__host__ __device__ __forceinline__ int perm32(int rho) { const int n = rho >> 4, i = rho & 15; return 8 * (i >> 2) + 4 * n + (i & 3); }

struct Unit { int pm, pn; };
struct Gemm { const bf16_t* A; const bf16_t* Bt; int M, N, K, lda, ldb; size_t kstepA, kstepB; const bf16_t* A2; int pm2; };

struct StaticOrder {
    int nM, nN, nwg, G, c;
    __device__ void init(int M, int N, int G_, int c_) { nM = M / BM; nN = N / BM; nwg = nM * nN; G = G_; c = c_; }
    __device__ bool next(int i, Unit& u) const {
        const long L = (long)i * G + c; if (L >= nwg) return false;
        int wgid = (int)L; { const int q = nwg / NXCD, r = nwg % NXCD, xcd = wgid % NXCD, off = wgid / NXCD; wgid = (xcd < r ? xcd * (q + 1) : r * (q + 1) + (xcd - r) * q) + off; }
        const int nig = WGM * nN, gid = wgid / nig, fm = gid * WGM, gsz = (nM - fm) < WGM ? (nM - fm) : WGM;
        u.pm = fm + ((wgid % nig) % gsz); u.pn = (wgid % nig) / gsz; return true;
    }
};

template <class Epi>
__device__ __forceinline__ void gemm_phase(LAS unsigned char* lds, const Gemm g, const StaticOrder& S, const Epi& E) {
    int tid = threadIdx.x; asm volatile("" : "+v"(tid));
    const int wid = __builtin_amdgcn_readfirstlane(tid >> 6), lane = tid & 63, wr = wid >> 2, wc = wid & 3, fr = lane & 15, fq = lane >> 4;
    const int K = g.K, nt = K / BK;
    unsigned voffA[2], voffB[2];
#pragma unroll
    for (int i = 0; i < 2; ++i) { int R, C; stage_rc(tid * 16 + i * 8192, R, C); const int Rb = Epi::PERM ? ((R & ~31) + perm32(R & 31)) : R;
        voffA[i] = (unsigned)(R * g.lda + C) * 2u; voffB[i] = (unsigned)(Rb * g.ldb + C) * 2u; }
    const size_t kstepA = g.kstepA, kstepB = g.kstepB;
    const size_t hstepA = (size_t)HALF * g.lda * 2, hstepB = (size_t)HALF * g.ldb * 2;
    const size_t tstepA = 2 * hstepA, tstepB = 2 * hstepB;
    const unsigned ldsw = (unsigned)wid * 1024u;
    const int aoff = lds_byte(wr * 64 + fr, fq * 8), boff = lds_byte(wc * 32 + fr, fq * 8);
#define PG8_SA(b, h) (((b) * 2 + (h)) * HTB)
#define PG8_SB(b, h) ((4 + (b) * 2 + (h)) * HTB)
#define PG8_STAGE(bufoff, gbase, voff) do { _Pragma("unroll") for (int _i = 0; _i < 2; ++_i) \
        __builtin_amdgcn_global_load_lds((const unsigned*)((const char*)(gbase) + (voff)[_i]), (LAS unsigned*)(lds + (bufoff) + ldsw + _i * 8192), 16, 0, 0); } while (0)
#define PG8_LDA(dst, b, h) do { _Pragma("unroll") for (int m = 0; m < 4; ++m) _Pragma("unroll") for (int k = 0; k < 2; ++k) dst[m][k] = *(const LAS bf16x8*)(lds + PG8_SA(b, h) + aoff + m * 2048 + k * 1024); } while (0)
#define PG8_LDB(dst, b, h) do { _Pragma("unroll") for (int n = 0; n < 2; ++n) _Pragma("unroll") for (int k = 0; k < 2; ++k) dst[n][k] = *(const LAS bf16x8*)(lds + PG8_SB(b, h) + boff + n * 2048 + k * 1024); } while (0)
#define PG8_MMA(ai, bj, At, Bt) do { __builtin_amdgcn_s_setprio(1); _Pragma("unroll") for (int m = 0; m < 4; ++m) _Pragma("unroll") for (int n = 0; n < 2; ++n) _Pragma("unroll") for (int k = 0; k < 2; ++k) \
        acc[ai][bj][m][n] = __builtin_amdgcn_mfma_f32_16x16x32_bf16(Bt[n][k], At[m][k], acc[ai][bj][m][n], 0, 0, 0); __builtin_amdgcn_s_setprio(0); } while (0)
#define PG8_WAIT_V(n) asm volatile("s_waitcnt vmcnt(" #n ")" ::: "memory")
#define PG8_WAIT_L(n) asm volatile("s_waitcnt lgkmcnt(" #n ")" ::: "memory")
#define PG8_BAR __builtin_amdgcn_s_barrier()
#define PG8_SCHED __builtin_amdgcn_sched_barrier(0)
    Unit cur, nxt; int ui = 0;
    if (!S.next(0, cur)) return;
    f32x4 acc[2][2][4][2];
#pragma unroll
    for (int a = 0; a < 2; ++a)
#pragma unroll
        for (int b = 0; b < 2; ++b)
#pragma unroll
            for (int m = 0; m < 4; ++m)
#pragma unroll
                for (int n = 0; n < 2; ++n) acc[a][b][m][n] = (f32x4){0.f, 0.f, 0.f, 0.f};
    bf16x8 At[4][2], B0[2][2], B1[2][2];
#define PG8_TILE_A(pm_) ((pm_) < g.pm2 ? (const char*)g.A + (size_t)(pm_) * tstepA : (const char*)g.A2 + (size_t)((pm_) - g.pm2) * tstepA)
    const char* cA = PG8_TILE_A(cur.pm); const char* cB = (const char*)g.Bt + (size_t)cur.pn * tstepB;
    E.prefetch(lds, cur, wid, lane);
    PG8_STAGE(PG8_SB(0, 0), cB, voffB); PG8_STAGE(PG8_SB(0, 1), cB + hstepB, voffB); PG8_STAGE(PG8_SA(0, 0), cA, voffA); PG8_STAGE(PG8_SA(0, 1), cA + hstepA, voffA);
    if (wr == 1) PG8_BAR;
    PG8_WAIT_V(2); PG8_BAR;
    PG8_STAGE(PG8_SB(1, 0), cB + kstepB, voffB); PG8_STAGE(PG8_SA(1, 0), cA + kstepA, voffA); PG8_STAGE(PG8_SB(1, 1), cB + hstepB + kstepB, voffB);
    PG8_WAIT_V(6); PG8_BAR;
    for (;;) {
        const bool has_next = S.next(ui + 1, nxt);
        const char* nA = has_next ? PG8_TILE_A(nxt.pm) : cA; const char* nB = has_next ? (const char*)g.Bt + (size_t)nxt.pn * tstepB : cB;
        for (int t = 0; t < nt; t += 2) {
            const bool last = (t == nt - 2);
            const char* a1 = cA + (size_t)(t + 1) * kstepA;
            const char* a2 = last ? nA : cA + (size_t)(t + 2) * kstepA; const char* b2 = last ? nB : cB + (size_t)(t + 2) * kstepB;
            const char* a3 = a2 + kstepA; const char* b3 = b2 + kstepB;
            PG8_LDB(B0, 0, 0); PG8_LDB(B1, 0, 1); PG8_SCHED; PG8_LDA(At, 0, 0); PG8_STAGE(PG8_SA(1, 1), a1 + hstepA, voffA);
            PG8_WAIT_V(8); PG8_WAIT_L(0); PG8_BAR; PG8_MMA(0, 0, At, B0); PG8_MMA(0, 1, At, B1); PG8_BAR; PG8_SCHED;
            PG8_LDA(At, 0, 1); PG8_STAGE(PG8_SB(0, 0), b2, voffB); PG8_STAGE(PG8_SB(0, 1), b2 + hstepB, voffB); PG8_STAGE(PG8_SA(0, 0), a2, voffA);
            PG8_WAIT_V(8); PG8_WAIT_L(0); PG8_BAR; PG8_MMA(1, 0, At, B0); PG8_MMA(1, 1, At, B1); PG8_BAR; PG8_SCHED;
            PG8_LDB(B0, 1, 0); PG8_LDB(B1, 1, 1); PG8_SCHED; PG8_LDA(At, 1, 0); PG8_STAGE(PG8_SA(0, 1), a2 + hstepA, voffA);
            PG8_WAIT_V(8); PG8_WAIT_L(0); PG8_BAR; PG8_MMA(0, 0, At, B0); PG8_MMA(0, 1, At, B1); PG8_BAR; PG8_SCHED;
            PG8_LDA(At, 1, 1); PG8_STAGE(PG8_SB(1, 0), b3, voffB); PG8_STAGE(PG8_SB(1, 1), b3 + hstepB, voffB); PG8_STAGE(PG8_SA(1, 0), a3, voffA);
            PG8_WAIT_V(8); PG8_WAIT_L(0); PG8_BAR; PG8_MMA(1, 0, At, B0); PG8_MMA(1, 1, At, B1); PG8_BAR; PG8_SCHED;
        }
        if (wr == 0) PG8_BAR;
        E(acc, cur, wr, wc, fr, fq, lds + (ui & 1) * 16384);
        if (!has_next) break;
#pragma unroll
        for (int a = 0; a < 2; ++a)
#pragma unroll
            for (int b = 0; b < 2; ++b)
#pragma unroll
                for (int m = 0; m < 4; ++m)
#pragma unroll
                    for (int n = 0; n < 2; ++n) acc[a][b][m][n] = (f32x4){0.f, 0.f, 0.f, 0.f};
        cur = nxt; cA = nA; cB = nB; ++ui;
        if (Epi::HAS_PREFETCH) E.prefetch(lds + (ui & 1) * 16384, cur, wid, lane);
        if (wr == 1) PG8_BAR;
    }
    PG8_WAIT_V(0);
    PG8_BAR;
#undef PG8_TILE_A
#undef PG8_SA
#undef PG8_SB
#undef PG8_STAGE
#undef PG8_LDA
#undef PG8_LDB
#undef PG8_MMA
#undef PG8_WAIT_V
#undef PG8_WAIT_L
#undef PG8_BAR
#undef PG8_SCHED
}
}

__device__ __forceinline__ void ssq_prefetch(LAS unsigned char* lds, const float* ssq, int row0, int wid_unused, int lane_unused) {
    int t2 = threadIdx.x; asm volatile("" : "+v"(t2));
    const int w2 = __builtin_amdgcn_readfirstlane(t2 >> 6), l2 = t2 & 63;
    (void)wid_unused; (void)lane_unused; (void)ssq;
    const float* ssq_k = (const float*)(*(unsigned char* const*)((const char*)__builtin_amdgcn_kernarg_segment_ptr() + 96) + WS_SSQ);
#pragma unroll
    for (int i = 0; i < 2; ++i)
        __builtin_amdgcn_global_load_lds((const unsigned*)((const char*)(ssq_k + (size_t)row0 * 16) + (w2 * 2 + i) * 1024 + l2 * 16), (LAS unsigned*)(lds + LDS_SSQ + (w2 * 2 + i) * 1024), 16, 0, 0);
}
__device__ __forceinline__ void rows_rstd(float (&rs)[2][4], LAS unsigned char* lds, int rowloc, int fq) {
#pragma unroll
    for (int ai = 0; ai < 2; ++ai) {
        f32x4 sp[4];
#pragma unroll
        for (int m = 0; m < 4; ++m) sp[m] = *(const LAS f32x4*)(lds + LDS_SSQ + ((rowloc + ai * 128 + m * 16) * 16 + fq * 4) * 4);
#pragma unroll
        for (int m = 0; m < 4; ++m) { float s = quad_sum((sp[m].x + sp[m].y) + (sp[m].z + sp[m].w)); rs[ai][m] = rsqrtf(s * (1.0f / D) + EPS); }
    }
}
struct EpiQKV {
    static constexpr bool PERM = true, HAS_PREFETCH = true;
    bf16_t* O; const f32x4* rope;
    __device__ __forceinline__ void prefetch(LAS unsigned char* l, const pg8::Unit& u, int wid, int lane) const { ssq_prefetch(l, nullptr, u.pm * 256, wid, lane); }
    __device__ __forceinline__ void operator()(const f32x4 (&acc)[2][2][4][2], const pg8::Unit& u, int wr, int wc, int fr, int fq, LAS unsigned char* lds) const {
        const int pn = u.pn;
        const float qs = (pn < 4) ? QSCALE : 1.f;
        const int col0 = pn * 256 + wc * 32 + 8 * fq;
        const int i0h = 8 * (wc & 1) + 2 * fq;
        const int rowbase = u.pm * 256 + wr * 64 + fr;
        float rs[2][4]; rows_rstd(rs, lds, wr * 64 + fr, fq);
        const bool rope0 = (pn == 2) || (pn == 3) || (pn == 8), rope1 = (pn == 2) || (pn == 3);
#pragma unroll
        for (int ai = 0; ai < 2; ++ai)
#pragma unroll
          for (int mh = 0; mh < 2; ++mh) {
            f32x4 r0[2], r1[2];
            if (rope0) {
#pragma unroll
                for (int mm = 0; mm < 2; ++mm) { const int row = rowbase + ai * 128 + (2 * mh + mm) * 16; const int pos = row < M_SPLIT ? (row & 8191) : (row & 16383);
                    const f32x4* rp = rope + (size_t)pos * 16 + i0h; r0[mm] = rp[0]; r1[mm] = rp[1]; }
            }
#pragma unroll
            for (int mm = 0; mm < 2; ++mm) {
                const int m = 2 * mh + mm;
                const int row = rowbase + ai * 128 + m * 16;
                const float rsc = rs[ai][m] * qs;
                bf16_t* rowp = O + (size_t)(col0 >> 6) * GSTRIDE + (size_t)row * 64 + (col0 & 63);
#pragma unroll
                for (int bj = 0; bj < 2; ++bj) {
                    f32x4 v0 = acc[ai][bj][m][0] * rsc, v1 = acc[ai][bj][m][1] * rsc;
                    if (bj == 0 ? rope0 : rope1) {
                        const f32x4 a0 = r0[mm], a1 = r1[mm];
                        v0 = (f32x4){v0.x * a0.x - v0.y * a0.y, v0.y * a0.x + v0.x * a0.y, v0.z * a0.z - v0.w * a0.w, v0.w * a0.z + v0.z * a0.w};
                        v1 = (f32x4){v1.x * a1.x - v1.y * a1.y, v1.y * a1.x + v1.x * a1.y, v1.z * a1.z - v1.w * a1.w, v1.w * a1.z + v1.z * a1.w};
                    }
                    u32x4 w; w.x = cvtpk(v0.x, v0.y); w.y = cvtpk(v0.z, v0.w); w.z = cvtpk(v1.x, v1.y); w.w = cvtpk(v1.z, v1.w);
                    *(u32x4*)(rowp + bj * 2 * GSTRIDE) = w;
                }
            }
          }
    }
};
struct EpiUp {
    static constexpr bool PERM = true, HAS_PREFETCH = true;
    bf16_t* O; bf16_t* O2;
    __device__ __forceinline__ void prefetch(LAS unsigned char* l, const pg8::Unit& u, int wid, int lane) const { ssq_prefetch(l, nullptr, u.pm * 256, wid, lane); }
    __device__ __forceinline__ void operator()(const f32x4 (&acc)[2][2][4][2], const pg8::Unit& u, int wr, int wc, int fr, int fq, LAS unsigned char* lds) const {
        const int col0 = u.pn * 256 + wc * 32 + 8 * fq;
        const int rowbase = u.pm * 256 + wr * 64 + fr;
        float rs[2][4]; rows_rstd(rs, lds, wr * 64 + fr, fq);
        bf16_t* obase = (u.pm < CHUNK_ROWS / 256) ? O : O2 - (size_t)CHUNK_ROWS * FF;
#pragma unroll
        for (int ai = 0; ai < 2; ++ai)
#pragma unroll
            for (int m = 0; m < 4; ++m) {
                const int rl = rowbase + ai * 128 + m * 16;
                const float rsc = rs[ai][m];
                bf16_t* rowp = obase + (size_t)rl * FF + col0;
#pragma unroll
                for (int bj = 0; bj < 2; ++bj) {
                    f32x4 v0 = acc[ai][bj][m][0] * rsc, v1 = acc[ai][bj][m][1] * rsc;
                    v0 = __builtin_elementwise_max(v0, (f32x4){0.f, 0.f, 0.f, 0.f}); v1 = __builtin_elementwise_max(v1, (f32x4){0.f, 0.f, 0.f, 0.f});
                    v0 = v0 * v0; v1 = v1 * v1;
                    u32x4 w; w.x = cvtpk(v0.x, v0.y); w.y = cvtpk(v0.z, v0.w); w.z = cvtpk(v1.x, v1.y); w.w = cvtpk(v1.z, v1.w);
                    __builtin_nontemporal_store(w, (u32x4*)(rowp + bj * 128));
                }
            }
    }
};
struct EpiRes {
    static constexpr bool PERM = true, HAS_PREFETCH = false;
    bf16_t* xb; float* ssq; int row0;
    __device__ __forceinline__ void prefetch(LAS unsigned char*, const pg8::Unit&, int, int) const {}
    __device__ __forceinline__ void operator()(const f32x4 (&acc)[2][2][4][2], const pg8::Unit& u, int wr, int wc, int fr, int fq, LAS unsigned char* lds) const {
        const int col0 = u.pn * 256 + wc * 32 + 8 * fq;
        const int rowbase = row0 + u.pm * 256 + wr * 64 + fr;
        u32x4 raw[2][2][2];
#define ERES_LOAD(slot, hb) do { _Pragma("unroll") for (int mm = 0; mm < 2; ++mm) _Pragma("unroll") for (int bj = 0; bj < 2; ++bj) \
            raw[slot][mm][bj] = *(const u32x4*)(xb + (size_t)(rowbase + ((hb) >> 1) * 128 + (2 * ((hb) & 1) + mm) * 16) * D + col0 + bj * 128); } while (0)
        ERES_LOAD(0, 0); ERES_LOAD(1, 1);
#pragma unroll
        for (int hb = 0; hb < 4; ++hb) {
            const int ai = hb >> 1, mh = hb & 1, slot = hb & 1;
#pragma unroll
            for (int mm = 0; mm < 2; ++mm) {
                const int m = 2 * mh + mm;
                const int row = rowbase + ai * 128 + m * 16;
                bf16_t* xp = xb + (size_t)row * D + col0;
                float s = 0.f;
#pragma unroll
                for (int bj = 0; bj < 2; ++bj) {
                    const u32x4 rw = raw[slot][mm][bj];
                    const f32x4 a0 = acc[ai][bj][m][0], a1 = acc[ai][bj][m][1];
                    u32x4 w;
                    w.x = cvtpk(__uint_as_float(rw.x << 16) + a0.x, __uint_as_float(rw.x & 0xffff0000u) + a0.y);
                    w.y = cvtpk(__uint_as_float(rw.y << 16) + a0.z, __uint_as_float(rw.y & 0xffff0000u) + a0.w);
                    w.z = cvtpk(__uint_as_float(rw.z << 16) + a1.x, __uint_as_float(rw.z & 0xffff0000u) + a1.y);
                    w.w = cvtpk(__uint_as_float(rw.w << 16) + a1.z, __uint_as_float(rw.w & 0xffff0000u) + a1.w);
                    *(u32x4*)(xp + bj * 128) = w;
#pragma unroll
                    for (int e = 0; e < 4; ++e) { const float lo = __uint_as_float(w[e] << 16), hi = __uint_as_float(w[e] & 0xffff0000u); s += lo * lo + hi * hi; }
                }
                s = quad_sum(s);
                if (fq == 0) ssq[(size_t)row * 16 + u.pn * 4 + wc] = s;
            }
            if (hb + 2 < 4) { if (slot == 0) ERES_LOAD(0, hb + 2); else ERES_LOAD(1, hb + 2); }
        }
#undef ERES_LOAD
    }
};

__device__ __forceinline__ f32x4 mfma16(bf16x8 a, bf16x8 b, f32x4 c) { return __builtin_amdgcn_mfma_f32_16x16x32_bf16(a, b, c, 0, 0, 0); }
typedef short v4i16_t __attribute__((ext_vector_type(4)));
__device__ __forceinline__ s16x4 tr_read(LAS unsigned char* p) { return __builtin_bit_cast(s16x4, __builtin_amdgcn_ds_read_tr16_b64_v4i16((LAS v4i16_t*)p)); }
__device__ __forceinline__ bf16x8 pack_p(const f32x4& a, const f32x4& b) {
    u32x4 w; w.x = cvtpk(a.x, a.y); w.y = cvtpk(a.z, a.w); w.z = cvtpk(b.x, b.y); w.w = cvtpk(b.z, b.w); return __builtin_bit_cast(bf16x8, w);
}
__device__ __forceinline__ void pv_pair(f32x4 (&o)[4], LAS unsigned char* vaddr, bf16x8 pf) {
#pragma unroll
    for (int db = 0; db < 4; ++db) {
        const s16x4 a = tr_read(vaddr + db * 32), b = tr_read(vaddr + 16 * KROW + db * 32);
        const bf16x8 vf = (bf16x8){a[0], a[1], a[2], a[3], b[0], b[1], b[2], b[3]};
        o[db] = mfma16(vf, pf, o[db]);
    }
}

struct VFrag { s16x4 a[4], b[4]; };
__device__ __forceinline__ void vfrag_load(VFrag& F, LAS unsigned char* va, const int (&off)[4], int blk2) {
#pragma unroll
    for (int db = 0; db < 4; ++db) { F.a[db] = tr_read(va + off[db]); F.b[db] = tr_read(va + blk2 + off[db]); }
}
__device__ __forceinline__ void vfrag_mma(f32x4 (&o)[4], const VFrag& F, bf16x8 pf) {
#pragma unroll
    for (int db = 0; db < 4; ++db) { const bf16x8 vf = (bf16x8){F.a[db][0], F.a[db][1], F.a[db][2], F.a[db][3], F.b[db][0], F.b[db][1], F.b[db][2], F.b[db][3]}; o[db] = mfma16(vf, pf, o[db]); }
}
struct NaPre { u32x4 k[2], v[2]; bf16x8 q0, q1; };
__device__ __forceinline__ int na_rs(int g) {
    const int glo = g < 128 ? 0 : (g < 256 ? 128 : (g < 512 ? 256 : 512));
    const int rows = g < 256 ? 128 : 256;
    int rs = g - 4; rs = rs < glo ? glo : rs; rs = rs > glo + rows - 8 ? glo + rows - 8 : rs;
    return rs;
}
__device__ __forceinline__ int na_tokmax(int g) { const int glo = g < 128 ? 0 : (g < 256 ? 128 : (g < 512 ? 256 : 512)), rows = g < 256 ? 128 : 256; return 64 * (glo + rows) - 1; }
__device__ __forceinline__ void na_load_q(NaPre& P, const bf16_t* QKV, int p, int tid) {
    const int h = p / 384, g0 = 2 * (p % 384);
    const int lane = tid & 63, w = tid >> 6, n = lane & 15, q4 = lane >> 4;
    const bf16_t* qp = QKV + (size_t)(G_QA + h) * GSTRIDE + ((size_t)(g0 + (w >> 2)) * 64 + 16 * (w & 3) + n) * 64;
    P.q0 = *(const bf16x8*)(qp + 8 * q4); P.q1 = *(const bf16x8*)(qp + 32 + 8 * q4);
}
__device__ __forceinline__ void na_load_rows(NaPre& P, const bf16_t* QKV, int h, int r0, int tokmax, int tid) {
    const bf16_t* kb = QKV + (size_t)(G_KA + h) * GSTRIDE;
#pragma unroll
    for (int i = 0; i < 2; ++i) { int tok = 64 * (r0 + i) + (tid >> 3); tok = tok > tokmax ? tokmax : tok;
        const bf16_t* p = kb + (size_t)tok * 64 + (tid & 7) * 8; P.k[i] = *(const u32x4*)p; P.v[i] = *(const u32x4*)(p + (G_VA - G_KA) * GSTRIDE); }
}
__device__ __forceinline__ void na_phase(LAS unsigned char* lds, bf16_t* QKV, const float* rpb_l, int G, int vcu, unsigned* probe_words) {
    int tid = threadIdx.x; asm volatile("" : "+v"(tid));
    const int lane = tid & 63, w = __builtin_amdgcn_readfirstlane(tid >> 6), n = lane & 15, q4 = lane >> 4;
    constexpr int NP = 3072;
    const int ppc = (NP + G - 1) / G, pbeg = vcu * ppc, pend = (pbeg + ppc) < NP ? (pbeg + ppc) : NP;
    if (pbeg >= pend) return;
    LAS float* bias = (LAS float*)(lds + LDS_BIAS);
    const int jc = w & 3, wrow = w >> 2;
    const int cb = jc == 0 ? 0 : (jc == 1 ? 8 : (jc == 2 ? 24 : 32));
    const int c = 16 * jc + n; int cs = c - 8; cs = cs < 0 ? 0 : cs; cs = cs > 48 ? 48 : cs;
    const int sw0 = ((q4) ^ (n & 7)) << 4, sw1 = ((4 + q4) ^ (n & 7)) << 4;
    const int rr = (4 * (q4 & 1) + (n >> 2)), pp = n & 3;
    int voff[4];
#pragma unroll
    for (int db = 0; db < 4; ++db) voff[db] = (((2 * db + (pp >> 1)) ^ rr) << 4) + (pp & 1) * 8;
    bool sel[4]; int coff[4]; unsigned m01 = 0u, m23 = 0u;
#pragma unroll
    for (int i = 0; i < 4; ++i) { const int kc0 = cb + 4 * q4 + i; sel[i] = (kc0 >= cs) && (kc0 < cs + 16); coff[i] = (sel[i] ? kc0 : kc0 + 16) - c + 15; }
    m01 = (sel[0] ? 0x0000ffffu : 0u) | (sel[1] ? 0xffff0000u : 0u); m23 = (sel[2] ? 0x0000ffffu : 0u) | (sel[3] ? 0xffff0000u : 0u);
    const int wtok = tid >> 3, wch = tid & 7, woff = wtok * 128 + ((wch ^ (wtok & 7)) << 4);
    NaPre P; na_load_q(P, QKV, pbeg, tid);
    int have_h = -1, have_lo = -100000;
    float bc[8][4]; int bc_key = -1000000;
#pragma unroll
    for (int j = 0; j < 8; ++j)
#pragma unroll
        for (int i = 0; i < 4; ++i) bc[j][i] = 0.f;
#ifdef PROBE_NA
    unsigned nt_prev = (unsigned)__builtin_amdgcn_s_memrealtime(), nA = 0u, nB = 0u, nC = 0u;
#define NSTAMP(x) do { const unsigned now_ = (unsigned)__builtin_amdgcn_s_memrealtime(); x += now_ - nt_prev; nt_prev = now_; } while (0)
#else
#define NSTAMP(x) do { } while (0)
#endif
    for (int p = pbeg; p < pend; ++p) {
        const int h = p / 384, g0 = 2 * (p % 384), g = g0 + wrow;
        const int rs0 = na_rs(g0), rsw = na_rs(g), tokmax = na_tokmax(g0);
        const int adv = rs0 - have_lo;
        if (h != have_h || adv < 0 || adv > 2) {
            const bf16_t* kb = QKV + (size_t)(G_KA + h) * GSTRIDE;
            u32x4 kr[9], vr[9];
#pragma unroll
            for (int i = 0; i < 9; ++i) { int tok = 64 * (rs0 + i) + wtok; tok = tok > tokmax ? tokmax : tok;
                const bf16_t* q = kb + (size_t)tok * 64 + wch * 8; kr[i] = *(const u32x4*)q; vr[i] = *(const u32x4*)(q + (G_VA - G_KA) * GSTRIDE); }
            if (h != have_h && tid < 465) bias[tid] = rpb_l[h * 465 + tid] * LOG2E;
#pragma unroll
            for (int i = 0; i < 9; ++i) { const int slot = (rs0 + i) % 9;
                *(LAS u32x4*)(lds + LDS_KS + slot * 8192 + woff) = kr[i]; *(LAS u32x4*)(lds + LDS_VS + slot * 8192 + woff) = vr[i]; }
        } else {
            if (adv >= 1) { const int slot = (have_lo + 9) % 9; *(LAS u32x4*)(lds + LDS_KS + slot * 8192 + woff) = P.k[0]; *(LAS u32x4*)(lds + LDS_VS + slot * 8192 + woff) = P.v[0]; }
            if (adv == 2) { const int slot = (have_lo + 10) % 9; *(LAS u32x4*)(lds + LDS_KS + slot * 8192 + woff) = P.k[1]; *(LAS u32x4*)(lds + LDS_VS + slot * 8192 + woff) = P.v[1]; }
        }
        have_h = h; have_lo = rs0;
        const bf16x8 qf0 = P.q0, qf1 = P.q1;
        __syncthreads();
        NSTAMP(nA);
        if (p + 1 < pend) { na_load_rows(P, QKV, h, rs0 + 9, tokmax, tid); na_load_q(P, QKV, p + 1, tid); }
        int sl[8];
        { const int b9 = rsw % 9;
#pragma unroll
          for (int j = 0; j < 8; ++j) { const int t = b9 + j; sl[j] = (t >= 9 ? t - 9 : t) * 8192; } }
        f32x4 s[8][2];
        {
            const LAS unsigned char* kb0 = lds + LDS_KS + (cb + n) * 128;
            bf16x8 kf[2][4][2];
#pragma unroll
            for (int tt = 0; tt < 4; ++tt) { const LAS unsigned char* kp = kb0 + sl[tt >> 1] + 16 * (tt & 1) * 128; kf[0][tt][0] = *(const LAS bf16x8*)(kp + sw0); kf[0][tt][1] = *(const LAS bf16x8*)(kp + sw1); }
#pragma unroll
            for (int c = 0; c < 4; ++c) {
                if (c + 1 < 4) {
#pragma unroll
                    for (int tt = 0; tt < 4; ++tt) { const LAS unsigned char* kp = kb0 + sl[2 * (c + 1) + (tt >> 1)] + 16 * (tt & 1) * 128;
                        kf[(c + 1) & 1][tt][0] = *(const LAS bf16x8*)(kp + sw0); kf[(c + 1) & 1][tt][1] = *(const LAS bf16x8*)(kp + sw1); }
                }
                __builtin_amdgcn_sched_barrier(0);
                f32x4 z[4];
#pragma unroll
                for (int tt = 0; tt < 4; ++tt) z[tt] = mfma16(kf[c & 1][tt][0], qf0, (f32x4){0.f, 0.f, 0.f, 0.f});
#pragma unroll
                for (int tt = 0; tt < 4; ++tt) z[tt] = mfma16(kf[c & 1][tt][1], qf1, z[tt]);
#pragma unroll
                for (int tt = 0; tt < 4; ++tt) s[2 * c + (tt >> 1)][tt & 1] = z[tt];
                __builtin_amdgcn_sched_barrier(0);
            }
        }
        const int bkey = (rsw - g) + 64 * h;
        if (bkey != bc_key) {
#pragma unroll
            for (int j = 0; j < 8; ++j)
#pragma unroll
                for (int i = 0; i < 4; ++i) bc[j][i] = bias[(rsw + j - g + 7) * 31 + coff[i]];
            bc_key = bkey;
        }
        f32x4 sm[8];
        float mx = -1e30f;
#pragma unroll
        for (int j = 0; j < 8; ++j)
#pragma unroll
            for (int i = 0; i < 4; ++i) {
                const float v = (sel[i] ? s[j][0][i] : s[j][1][i]) + bc[j][i];
                sm[j][i] = v; mx = fmaxf(mx, v);
            }
        mx = quad_max(mx);
        NSTAMP(nB);
        float l = 0.f;
#pragma unroll
        for (int j = 0; j < 8; ++j)
#pragma unroll
            for (int i = 0; i < 4; ++i) { const float pe = __builtin_amdgcn_exp2f(sm[j][i] - mx); sm[j][i] = pe; l += pe; }
        l = quad_sum(l);
        f32x4 o[4];
#pragma unroll
        for (int db = 0; db < 4; ++db) o[db] = (f32x4){0.f, 0.f, 0.f, 0.f};
        {
            LAS unsigned char* vbase = lds + LDS_VS + (cb + 4 * q4 + (n >> 2)) * 128;
            VFrag F0, F1; vfrag_load(F0, vbase + sl[0], voff, 16 * 128);
#pragma unroll
            for (int j = 0; j < 8; ++j) {
                if (j + 1 < 8) { if ((j & 1) == 0) vfrag_load(F1, vbase + sl[j + 1], voff, 16 * 128); else vfrag_load(F0, vbase + sl[j + 1], voff, 16 * 128); }
                const unsigned p01 = cvtpk(sm[j][0], sm[j][1]), p23 = cvtpk(sm[j][2], sm[j][3]);
                u32x4 pw; pw.x = p01 & m01; pw.y = p23 & m23; pw.z = p01 & ~m01; pw.w = p23 & ~m23;
                const bf16x8 pf = __builtin_bit_cast(bf16x8, pw);
                if ((j & 1) == 0) vfrag_mma(o, F0, pf); else vfrag_mma(o, F1, pf);
            }
        }
        const float inv = 1.0f / l;
        bf16_t* qp = QKV + (size_t)(G_QA + h) * GSTRIDE + ((size_t)g * 64 + 16 * jc + n) * 64;
#pragma unroll
        for (int db = 0; db < 4; ++db) {
            const f32x4 v = o[db] * inv;
            u32x2 wv; wv.x = cvtpk(v.x, v.y); wv.y = cvtpk(v.z, v.w);
            *(u32x2*)(qp + 16 * db + 4 * q4) = wv;
        }
        __syncthreads();
        NSTAMP(nC);
    }
#ifdef PROBE_NA
    if (blockIdx.x == 0 && tid == 0) { unsigned* bw = (unsigned*)probe_words; atomicAdd(bw + 10, nA); atomicAdd(bw + 11, nB); atomicAdd(bw + 12, nC); }
#endif
}

constexpr int SWA_KEYS = 336;
struct SwaPre { u32x4 k[6], v[6]; bf16x8 q[2][2]; float sink; };
__device__ __forceinline__ void swa_issue(SwaPre& P, const bf16_t* QKV, const float* sink_l, int u, int tid) {
    const int kvh = u / 768, P0 = 64 * (u % 768);
    const int slo = P0 < 8192 ? 0 : (P0 < 16384 ? 8192 : (P0 < 32768 ? 16384 : 32768));
    const int shi = P0 < 8192 ? 8192 : (P0 < 16384 ? 16384 : (P0 < 32768 ? 32768 : 49152));
#pragma unroll
    for (int i = 0; i < 6; ++i) { const int idx = tid + 512 * i, kidx = idx >> 3, ch = idx & 7; const int tok = P0 - 128 + kidx;
        const bool ok = (idx < SWA_KEYS * 8) && tok >= slo && tok < shi;
        const bf16_t* p = QKV + (size_t)(G_KS + kvh) * GSTRIDE + (size_t)(ok ? tok : P0) * 64 + ch * 8;
        P.k[i] = *(const u32x4*)p; P.v[i] = *(const u32x4*)(p + (G_VS - G_KS) * GSTRIDE); }
    const int lane = tid & 63, w = tid >> 6, n = lane & 15, q4 = lane >> 4;
#pragma unroll
    for (int sub = 0; sub < 2; ++sub) {
        const bf16_t* qp = QKV + (size_t)(G_QS + 4 * kvh + (w & 3)) * GSTRIDE + (size_t)(P0 + 16 * ((w >> 2) + 2 * sub) + n) * 64;
        P.q[sub][0] = *(const bf16x8*)(qp + 8 * q4); P.q[sub][1] = *(const bf16x8*)(qp + 32 + 8 * q4); }
    P.sink = sink_l[4 * kvh + (w & 3)];
}
__device__ __forceinline__ void swa_task(LAS unsigned char* lds, bf16_t* QKV, bf16x8 qf0, bf16x8 qf1, float sinkv, int hq, int P0, int pg, int slo, int shi, int n, int q4) {
    const int p0 = P0 + 16 * pg;
    f32x4 s[9][2];
    s[8][1] = (f32x4){-1e30f, -1e30f, -1e30f, -1e30f};
    {
        const LAS unsigned char* kb0 = lds + LDS_KS + (16 * pg + n) * KROW + q4 * 16;
        bf16x8 kf[2][4][2];
#pragma unroll
        for (int tt = 0; tt < 4; ++tt) { kf[0][tt][0] = *(const LAS bf16x8*)(kb0 + 16 * tt * KROW); kf[0][tt][1] = *(const LAS bf16x8*)(kb0 + 16 * tt * KROW + 64); }
#pragma unroll
        for (int c = 0; c < 5; ++c) {
            if (c + 1 < 5) {
#pragma unroll
                for (int tt = 0; tt < 4; ++tt) { const int tau = 4 * (c + 1) + tt;
                    if (tau < 17) { kf[(c + 1) & 1][tt][0] = *(const LAS bf16x8*)(kb0 + 16 * tau * KROW); kf[(c + 1) & 1][tt][1] = *(const LAS bf16x8*)(kb0 + 16 * tau * KROW + 64); } }
            }
            __builtin_amdgcn_sched_barrier(0);
            f32x4 z[4];
#pragma unroll
            for (int tt = 0; tt < 4; ++tt) if (4 * c + tt < 17) z[tt] = mfma16(kf[c & 1][tt][0], qf0, (f32x4){0.f, 0.f, 0.f, 0.f});
#pragma unroll
            for (int tt = 0; tt < 4; ++tt) if (4 * c + tt < 17) z[tt] = mfma16(kf[c & 1][tt][1], qf1, z[tt]);
#pragma unroll
            for (int tt = 0; tt < 4; ++tt) { const int tau = 4 * c + tt; if (tau < 17) s[tau >> 1][tau & 1] = z[tt]; }
            __builtin_amdgcn_sched_barrier(0);
        }
    }
    const bool edge = (p0 - 128 < slo) || (p0 + 144 > shi);
    if (__builtin_amdgcn_readfirstlane((int)edge)) {
#pragma unroll
        for (int j = 0; j < 9; ++j)
#pragma unroll
            for (int t = 0; t < 2; ++t)
#pragma unroll
                for (int i = 0; i < 4; ++i) { const int key = p0 - 128 + 32 * j + 16 * t + 4 * q4 + i; s[j][t][i] = (key >= slo && key < shi) ? s[j][t][i] : -1e30f; }
        asm volatile("" ::: "memory");
    }
    float mx = -1e30f;
#pragma unroll
    for (int j = 0; j < 9; ++j)
#pragma unroll
        for (int t = 0; t < 2; ++t)
#pragma unroll
            for (int i = 0; i < 4; ++i) {
                if (j == 8 && t == 1) continue;
                float v = s[j][t][i];
                if (j == 0 && t == 0) v = (4 * q4 + i < n) ? -1e30f : v;
                if (j == 8) v = (4 * q4 + i > n) ? -1e30f : v;
                s[j][t][i] = v; mx = fmaxf(mx, v);
            }
    mx = quad_max(mx);
    mx = fmaxf(mx, sinkv);
    float l = 0.f;
#pragma unroll
    for (int j = 0; j < 9; ++j)
#pragma unroll
        for (int t = 0; t < 2; ++t)
#pragma unroll
            for (int i = 0; i < 4; ++i) { if (j == 8 && t == 1) { s[j][t][i] = 0.f; continue; } const float p = __builtin_amdgcn_exp2f(s[j][t][i] - mx); s[j][t][i] = p; l += p; }
    l = quad_sum(l);
    l += __builtin_amdgcn_exp2f(sinkv - mx);
    f32x4 o[4];
#pragma unroll
    for (int db = 0; db < 4; ++db) o[db] = (f32x4){0.f, 0.f, 0.f, 0.f};
    {
        LAS unsigned char* vbase = lds + LDS_VS + (16 * pg + 4 * q4 + (n >> 2)) * KROW + (n & 3) * 8;
        const int voff4[4] = {0, 32, 64, 96};
        VFrag F0, F1; vfrag_load(F0, vbase, voff4, 16 * KROW);
#pragma unroll
        for (int j = 0; j < 9; ++j) {
            if (j + 1 < 9) { if ((j & 1) == 0) vfrag_load(F1, vbase + 32 * (j + 1) * KROW, voff4, 16 * KROW); else vfrag_load(F0, vbase + 32 * (j + 1) * KROW, voff4, 16 * KROW); }
            const bf16x8 pf = pack_p(s[j][0], s[j][1]);
            if ((j & 1) == 0) vfrag_mma(o, F0, pf); else vfrag_mma(o, F1, pf);
        }
    }
    const float inv = 1.0f / l;
    bf16_t* qp = QKV + (size_t)(G_QS + hq) * GSTRIDE + (size_t)(p0 + n) * 64;
#pragma unroll
    for (int db = 0; db < 4; ++db) {
        const f32x4 v = o[db] * inv;
        u32x2 wv; wv.x = cvtpk(v.x, v.y); wv.y = cvtpk(v.z, v.w);
        *(u32x2*)(qp + 16 * db + 4 * q4) = wv;
    }
}
__device__ __forceinline__ void swa_phase(LAS unsigned char* lds, bf16_t* QKV, const float* sink_l, int G, int bx) {
    int tid = threadIdx.x; asm volatile("" : "+v"(tid));
    const int lane = tid & 63, w = __builtin_amdgcn_readfirstlane(tid >> 6), n = lane & 15, q4 = lane >> 4;
    constexpr int NU = 1536;
    if (bx >= NU) return;
    SwaPre P; swa_issue(P, QKV, sink_l, bx, tid);
    for (int u = bx; u < NU; u += G) {
        const int kvh = u / 768, P0 = 64 * (u % 768);
        const int slo = P0 < 8192 ? 0 : (P0 < 16384 ? 8192 : (P0 < 32768 ? 16384 : 32768));
        const int shi = P0 < 8192 ? 8192 : (P0 < 16384 ? 16384 : (P0 < 32768 ? 32768 : 49152));
#pragma unroll
        for (int i = 0; i < 6; ++i) { const int idx = tid + 512 * i, kidx = idx >> 3, ch = idx & 7; const int tok = P0 - 128 + kidx; const bool ok = tok >= slo && tok < shi;
            const u32x4 z = (u32x4){0u, 0u, 0u, 0u};
            if (idx < SWA_KEYS * 8) { *(LAS u32x4*)(lds + LDS_KS + kidx * KROW + ch * 16) = ok ? P.k[i] : z; *(LAS u32x4*)(lds + LDS_VS + kidx * KROW + ch * 16) = ok ? P.v[i] : z; } }
        const float sinkv = P.sink * LOG2E;
        const int hq = 4 * kvh + (w & 3);
        __syncthreads();
        swa_task(lds, QKV, P.q[0][0], P.q[0][1], sinkv, hq, P0, (w >> 2), slo, shi, n, q4);
        const bf16x8 qb0 = P.q[1][0], qb1 = P.q[1][1];
        if (u + G < NU) swa_issue(P, QKV, sink_l, u + G, tid);
        swa_task(lds, QKV, qb0, qb1, sinkv, hq, P0, (w >> 2) + 2, slo, shi, n, q4);
        __syncthreads();
    }
}

__device__ __forceinline__ int win_src(int n) {
    if (n < 512) return n;
    if (n < 1024) { const int p = n - 512, pp = p & 63; return 1536 + (p & ~63) + (pp >> 1) + ((pp & 1) << 5); }
    if (n < 1536) return 512 + (n - 1024);
    if (n < 2048) return 1024 + (n - 1536);
    if (n < 2176) { const int p = n - 2048, pp = p & 63; return 2048 + (p & ~63) + (pp >> 1) + ((pp & 1) << 5); }
    return n;
}
struct TDesc { const float* W; bf16_t* WT; const float* gain; int K, N, k0, n0, src; };
struct TRegs { float wv[32]; f32x4 ga, gb; };
__device__ __forceinline__ void transpose_load(TRegs& R, const TDesc& d, int lane) {
    const int c = lane & 7;
    R.ga = (f32x4){1.f, 1.f, 1.f, 1.f}; R.gb = R.ga;
    if (d.gain) { R.ga = *(const f32x4*)(d.gain + d.k0 + 8 * c); R.gb = *(const f32x4*)(d.gain + d.k0 + 8 * c + 4); }
#pragma unroll
    for (int i = 0; i < 32; ++i) R.wv[i] = d.W[(size_t)(d.k0 + 2 * i + (lane >> 5)) * d.N + d.src];
}
__device__ __forceinline__ void transpose_finish(const TRegs& R, const TDesc& d, LAS float* scr, int lane) {
    const int c = lane & 7;
#pragma unroll
    for (int i = 0; i < 32; ++i) scr[(2 * i + (lane >> 5)) * 33 + (lane & 31)] = R.wv[i];
    asm volatile("s_waitcnt lgkmcnt(0)" ::: "memory");
#pragma unroll
    for (int j = 0; j < 4; ++j) { const int n = (lane >> 3) + 8 * j; const LAS float* sp = scr + (8 * c) * 33 + n;
        u32x4 o; o.x = cvtpk(sp[0 * 33] * R.ga.x, sp[1 * 33] * R.ga.y); o.y = cvtpk(sp[2 * 33] * R.ga.z, sp[3 * 33] * R.ga.w); o.z = cvtpk(sp[4 * 33] * R.gb.x, sp[5 * 33] * R.gb.y); o.w = cvtpk(sp[6 * 33] * R.gb.z, sp[7 * 33] * R.gb.w);
        *(u32x4*)(d.WT + (size_t)(d.n0 + n) * d.K + d.k0 + 8 * c) = o; }
    asm volatile("s_waitcnt lgkmcnt(0)" ::: "memory");
}
__device__ __forceinline__ void sincos_acc(float ang, float& co, float& si) {
    const double a = (double)ang;
    const double q = __builtin_rint(a * 0.63661977236758134308);
    double r = __builtin_fma(-q, 1.57079632679489655800e+00, a); r = __builtin_fma(-q, 6.12323399573676603587e-17, r);
    const double r2 = r * r;
    double sp = -2.50521083854417187751e-08; sp = sp * r2 + 2.75573192239858906526e-06; sp = sp * r2 - 1.98412698412698412698e-04; sp = sp * r2 + 8.33333333333333333333e-03; sp = sp * r2 - 1.66666666666666666667e-01;
    const double sn = r + r * r2 * sp;
    double cp = 2.08767569878680989792e-09; cp = cp * r2 - 2.75573192239858906526e-07; cp = cp * r2 + 2.48015873015873015873e-05; cp = cp * r2 - 1.38888888888888888889e-03; cp = cp * r2 + 4.16666666666666666667e-02; cp = cp * r2 - 0.5;
    const double cn = 1.0 + r2 * cp;
    const int qi = ((int)q) & 3;
    const double c2 = (qi == 0) ? cn : (qi == 1) ? -sn : (qi == 2) ? -cn : sn;
    const double s2 = (qi == 0) ? sn : (qi == 1) ? cn : (qi == 2) ? -sn : -cn;
    co = (float)c2; si = (float)s2;
}

#define XB_TMO      128
#define XB_XCNT(j)  (256  + 64 * (j))
#define XB_XSUB(j)  (1280 + 64 * (j))
#define XB_XGEN(j)  (2304 + 64 * (j))
#define XB_TOP      3328
#define XB_TOPGEN   3392
#define XCD_BAR_WORDS 3456
#define XB_SPIN_CAP (1u << 18)
__device__ __forceinline__ unsigned xb_ld(unsigned* p)              { return __hip_atomic_load(p, __ATOMIC_RELAXED, __HIP_MEMORY_SCOPE_AGENT); }
__device__ __forceinline__ unsigned xb_add(unsigned* p, unsigned v) { return __hip_atomic_fetch_add(p, v, __ATOMIC_RELAXED, __HIP_MEMORY_SCOPE_AGENT); }
__device__ __forceinline__ unsigned xb_xcc_id() { return (unsigned)__builtin_amdgcn_s_getreg((3 << 11) | 20) & 0xFu; }
#define XB_SPIN(cond, bar) do { unsigned _sp = 0; while (cond) { __builtin_amdgcn_s_sleep(1); \
    if ((++_sp & 255u) == 0u) { if (xb_ld(&(bar)[XB_TMO])) break; if (_sp > XB_SPIN_CAP) { atomicAdd(&(bar)[XB_TMO], 1u); break; } } } } while (0)
struct XcdBarrier { unsigned* bar; unsigned x; unsigned* st; };
__device__ __forceinline__ XcdBarrier xcd_barrier_post(unsigned* bar, unsigned* st) {
    XcdBarrier b; b.bar = bar; b.x = xb_xcc_id(); b.st = st;
    if (threadIdx.x == 0) { (void)xb_add(&bar[XB_XCNT(b.x)], 1u);
    }
    return b;
}
__device__ __forceinline__ void xcd_barrier_complete(unsigned* bar, unsigned x, unsigned& nloc, unsigned& nx) {
    const unsigned G = gridDim.x * gridDim.y * gridDim.z;
    unsigned sum, cnt, mine, sp = 0u;
    for (;;) {
        sum = 0u; cnt = 0u; mine = 0u;
#pragma unroll
        for (unsigned j = 0; j < 16; ++j) { const unsigned c = xb_ld(&bar[XB_XCNT(j)]); sum += c; cnt += (c > 0u) ? 1u : 0u; mine = (j == x) ? c : mine; }
        if (sum == G) break;
        __builtin_amdgcn_s_sleep(1);
        if ((++sp & 255u) == 0u) { if (xb_ld(&bar[XB_TMO])) break; if (sp > XB_SPIN_CAP) { atomicAdd(&bar[XB_TMO], 1u); break; } }
    }
    nloc = mine > 0u ? mine : 1u; nx = cnt > 0u ? cnt : 1u;
}
__device__ __forceinline__ void xcd_barrier(const XcdBarrier& b, unsigned& nloc_s, unsigned& nx_s) {
    asm volatile("s_waitcnt vmcnt(0)" ::: "memory");
    __syncthreads();
    if (threadIdx.x == 0) {
        unsigned* bar = b.bar;
        __builtin_amdgcn_s_waitcnt(0);
        unsigned nloc = nloc_s, nx = nx_s;
        if (nloc == 0u) { xcd_barrier_complete(bar, b.x, nloc, nx); nloc_s = nloc; nx_s = nx; }
        const unsigned old = xb_add(&bar[XB_XSUB(b.x)], 1u);
        const unsigned gen = old / nloc;
        if (old + 1u == (gen + 1u) * nloc) {
            __builtin_amdgcn_fence(__ATOMIC_RELEASE, "agent");
            asm volatile("s_waitcnt vmcnt(0)" ::: "memory");
            const unsigned og = xb_add(&bar[XB_TOP], 1u);
            const unsigned tg = og / nx;
            if (og + 1u == (tg + 1u) * nx) xb_add(&bar[XB_TOPGEN], 1u);
            else XB_SPIN(xb_ld(&bar[XB_TOPGEN]) == tg, bar);
            __builtin_amdgcn_fence(__ATOMIC_ACQUIRE, "agent");
            xb_add(&bar[XB_XGEN(b.x)], 1u);
            asm volatile("s_waitcnt vmcnt(0)" ::: "memory");
        } else {
            XB_SPIN(xb_ld(&bar[XB_XGEN(b.x)]) == gen, bar);
            __builtin_amdgcn_fence(__ATOMIC_ACQUIRE, "agent");
            asm volatile("s_waitcnt vmcnt(0)" ::: "memory");
        }
    }
    nloc_s = __builtin_amdgcn_readfirstlane(nloc_s); nx_s = __builtin_amdgcn_readfirstlane(nx_s);
    __syncthreads();
}

struct Args {
    const float* xp; const float* xs; const float* norm_mix; const float* w_in; const float* rpb; const float* sink; const float* w_out;
    const float* norm_mlp; const float* w_up; const float* w_down; const float* norm_final;
    float* out; unsigned char* ws;
    float inv_freq[32];
};

constexpr int I_IN_ITEMS = (D / 64) * (NIN / 32), I_OUT_ITEMS = (D / 64) * (D / 32), I_UP_ITEMS = (D / 64) * (FF / 32), I_DN_ITEMS = (FF / 64) * (D / 32);
constexpr int I_LAYER_ITEMS = I_IN_ITEMS + I_OUT_ITEMS + I_UP_ITEMS + I_DN_ITEMS;
__device__ __forceinline__ void convert_items(int it_begin, int it_end, int widx, int nw, LAS float* scr, int lane) {
    const Args& a = *(const Args*)__builtin_amdgcn_kernarg_segment_ptr();
    unsigned char* wsb = a.ws; asm volatile("" : "+s"(wsb));
    bf16_t* Win = (bf16_t*)(wsb + WS_WIN); bf16_t* Wout = (bf16_t*)(wsb + WS_WOUT); bf16_t* Wup = (bf16_t*)(wsb + WS_WUP); bf16_t* Wdn = (bf16_t*)(wsb + WS_WDN);
    auto decode = [&](int it) -> TDesc {
        const int l = it / I_LAYER_ITEMS; int r = it % I_LAYER_ITEMS;
        TDesc d; bool inmap = false;
        if (r < I_IN_ITEMS) { d.W = a.w_in + (size_t)l * D * NIN; d.K = D; d.N = NIN; d.WT = Win + (size_t)l * NIN * D; d.gain = a.norm_mix + l * D; inmap = true; }
        else if ((r -= I_IN_ITEMS) < I_OUT_ITEMS) { d.W = a.w_out + (size_t)l * D * D; d.K = D; d.N = D; d.WT = Wout + (size_t)l * D * D; d.gain = nullptr; }
        else if ((r -= I_OUT_ITEMS) < I_UP_ITEMS) { d.W = a.w_up + (size_t)l * D * FF; d.K = D; d.N = FF; d.WT = Wup + (size_t)l * FF * D; d.gain = a.norm_mlp + l * D; }
        else { r -= I_UP_ITEMS; d.W = a.w_down + (size_t)l * FF * D; d.K = FF; d.N = D; d.WT = Wdn + (size_t)l * D * FF; d.gain = nullptr; }
        const int nblk = d.N / 32; d.k0 = 64 * (r / nblk); d.n0 = 32 * (r % nblk);
        const int nphys = d.n0 + (lane & 31); d.src = inmap ? win_src(nphys) : nphys;
        return d;
    };
    int it = it_begin + widx;
    if (it < it_end) {
        TRegs RA, RB; TDesc dA = decode(it), dB = dA; transpose_load(RA, dA, lane);
        for (;;) {
            const int it1 = it + nw; const bool h1 = it1 < it_end;
            if (h1) { dB = decode(it1); transpose_load(RB, dB, lane); }
            transpose_finish(RA, dA, scr, lane);
            if (!h1) break;
            const int it2 = it1 + nw; const bool h2 = it2 < it_end;
            if (h2) { dA = decode(it2); transpose_load(RA, dA, lane); }
            transpose_finish(RB, dB, scr, lane);
            if (!h2) break;
            it = it2;
        }
    }
}

static_assert(__builtin_offsetof(Args, ws) == 96, "ssq_prefetch reads Args::ws from the kernel-argument segment at byte 96");
__global__ void __launch_bounds__(512, 2) mega_fwd(Args a) {
    extern __shared__ __attribute__((aligned(16))) unsigned char lds_raw[];
    LAS unsigned char* lds = (LAS unsigned char*)lds_raw;
    cg::grid_group grid = cg::this_grid();
    const int tid = threadIdx.x, lane = tid & 63, wave = __builtin_amdgcn_readfirstlane(tid >> 6);
    const int G = gridDim.x, bx = blockIdx.x;
    const int gw = bx * 8 + wave, NGW = G * 8;
    unsigned char* ws = a.ws;
    float* rope = (float*)(ws + WS_ROPE); float* ssq = (float*)(ws + WS_SSQ);
    bf16_t* Win = (bf16_t*)(ws + WS_WIN); bf16_t* Wout = (bf16_t*)(ws + WS_WOUT); bf16_t* Wup = (bf16_t*)(ws + WS_WUP); bf16_t* Wdn = (bf16_t*)(ws + WS_WDN);
    bf16_t* XB = (bf16_t*)(ws + WS_XB); bf16_t* QKV = (bf16_t*)(ws + WS_QKV); bf16_t* HB = (bf16_t*)(ws + WS_H);
    float* out = a.out;
#ifdef PROBE_F1
    const unsigned pt_start = (unsigned)__builtin_amdgcn_s_memrealtime();
#endif
    unsigned* barw = (unsigned*)ws;
    if (bx == 0) for (int i = tid; i < XCD_BAR_WORDS + 2 * G; i += 512) barw[i] = 0u;
    unsigned* bst = barw + XCD_BAR_WORDS + 2 * bx;

    {
        LAS float* scr = (LAS float*)(lds + wave * 16384);
        constexpr int I_IN = (D / 64) * (NIN / 32), I_OUT = (D / 64) * (D / 32), I_UP = (D / 64) * (FF / 32), I_DN = (FF / 64) * (D / 32);
        constexpr int I_LAYER = I_IN + I_OUT + I_UP + I_DN;
        convert_items(0, I_LAYER_ITEMS, gw, NGW, scr, lane);
        for (int row = gw; row < M_TOT; row += NGW) {
            const float* xr = (row < M_SPLIT ? a.xp + (size_t)row * D : a.xs + (size_t)(row - M_SPLIT) * D);
            float s = 0.f;
#pragma unroll
            for (int j = 0; j < 4; ++j) { const f32x4 v = *(const f32x4*)(xr + 4 * lane + 256 * j);
                u32x2 wv; wv.x = cvtpk(v.x, v.y); wv.y = cvtpk(v.z, v.w); *(u32x2*)(XB + (size_t)row * D + 4 * lane + 256 * j) = wv;
                const float r0 = __uint_as_float(wv.x << 16), r1 = __uint_as_float(wv.x & 0xffff0000u), r2 = __uint_as_float(wv.y << 16), r3 = __uint_as_float(wv.y & 0xffff0000u);
                s += (r0 * r0 + r1 * r1) + (r2 * r2 + r3 * r3); }
            s = wave_sum(s);
            if (lane < 16) ssq[(size_t)row * 16 + lane] = (lane == 0) ? s : 0.f;
        }
        for (int e = bx * 512 + tid; e < 16384 * 32; e += G * 512) {
            const int pos = e >> 5, i = e & 31; float co, si; sincos_acc((float)pos * a.inv_freq[i], co, si);
            rope[2 * e] = co; rope[2 * e + 1] = si;
        }
    }
    grid.sync();
    const XcdBarrier xbar = xcd_barrier_post(barw, bst);
    unsigned bar_nloc = 0u, bar_nx = 0u;
#ifdef PROBE_F1
    unsigned pt_prev = (unsigned)__builtin_amdgcn_s_memrealtime(), pT1 = 0u, pT2 = 0u, ptot = 0u;
    { const unsigned d0 = pt_prev - pt_start; ptot += d0; if (PROBE_F1 == 0) pT1 += d0; if (PROBE_F2 == 0) pT2 += d0; }
#define STAMP(cat) do { const unsigned now_ = (unsigned)__builtin_amdgcn_s_memrealtime(); const unsigned d_ = now_ - pt_prev; pt_prev = now_; ptot += d_; if ((cat) == PROBE_F1) pT1 += d_; if ((cat) == PROBE_F2) pT2 += d_; } while (0)
#else
#define STAMP(cat) do { } while (0)
#endif

    for (int l = 0; l < DEPTH; ++l) {
        {
            pg8::Gemm g{XB, Win + (size_t)l * NIN * D, M_TOT, NIN, D, D, D, 128, 128, XB, 1 << 30}; pg8::StaticOrder S; S.init(M_TOT, NIN, G, bx);
            EpiQKV E{QKV, (const f32x4*)rope};
#ifndef NO_G1
            pg8::gemm_phase<EpiQKV>(lds, g, S, E);
#endif
        }
        if (l + 1 < DEPTH) {
            const int nwg = (M_TOT / 256) * (NIN / 256), full = nwg % G;
            int tidc = threadIdx.x; asm volatile("" : "+v"(tidc));
            const int wv_ = __builtin_amdgcn_readfirstlane(tidc >> 6), ln_ = tidc & 63;
            if (full == 0) convert_items((l + 1) * I_LAYER_ITEMS, (l + 2) * I_LAYER_ITEMS, bx * 8 + wv_, G * 8, (LAS float*)(lds + wv_ * 16384), ln_);
            else if (bx >= full) convert_items((l + 1) * I_LAYER_ITEMS, (l + 2) * I_LAYER_ITEMS, (bx - full) * 8 + wv_, (G - full) * 8, (LAS float*)(lds + wv_ * 16384), ln_);
        }
        xcd_barrier(xbar, bar_nloc, bar_nx);
        STAMP(1);
        {
            const float* rpb_l = a.rpb + (size_t)l * 8 * 465; const float* sink_l = a.sink + l * 8;
            const int vcu = (G % 8 == 0) ? (bx % 8) * (G / 8) + bx / 8 : bx;
            na_phase(lds, QKV, rpb_l, G, vcu, barw);
            STAMP(2);
            swa_phase(lds, QKV, sink_l, G, vcu);
        }
        xcd_barrier(xbar, bar_nloc, bar_nx);
        STAMP(6);
        {
            pg8::Gemm g{QKV, Wout + (size_t)l * D * D, M_TOT, D, D, 64, D, (size_t)M_TOT * 128, 128, QKV, 1 << 30};
            pg8::StaticOrder S; S.init(M_TOT, D, G, bx);
            EpiRes E{XB, ssq, 0};
#ifndef NO_G2
            pg8::gemm_phase<EpiRes>(lds, g, S, E);
#endif
        }
        xcd_barrier(xbar, bar_nloc, bar_nx);
        STAMP(3);
        {
            pg8::Gemm g{XB, Wup + (size_t)l * FF * D, M_TOT, FF, D, D, D, 128, 128, XB, 1 << 30}; pg8::StaticOrder S; S.init(M_TOT, FF, G, bx);
            EpiUp E{HB, (bf16_t*)out};
#ifndef NO_G3
            pg8::gemm_phase<EpiUp>(lds, g, S, E);
#endif
        }
        xcd_barrier(xbar, bar_nloc, bar_nx);
        STAMP(4);
        {
            pg8::Gemm g{HB, Wdn + (size_t)l * D * FF, M_TOT, D, FF, FF, FF, 128, 128, (const bf16_t*)out, CHUNK_ROWS / 256}; pg8::StaticOrder S; S.init(M_TOT, D, G, bx);
            EpiRes E{XB, ssq, 0};
#ifndef NO_G4
            pg8::gemm_phase<EpiRes>(lds, g, S, E);
#endif
        }
#ifdef PROBE_NA
        if (l == DEPTH - 1 && bx == 0 && tid == 0) { const float tA = (float)xb_ld(barw + 10), tB = (float)xb_ld(barw + 11), tC = (float)xb_ld(barw + 12), tt = tA + tB + tC;
            const float V = floorf(tA / tt * 64.f) * (1.f / 64.f) + (tB / tt) * (1.f / 64.f);
            __hip_atomic_store((float*)(barw + 8), V, __ATOMIC_RELAXED, __HIP_MEMORY_SCOPE_AGENT); }
#endif
#ifdef PROBE_F1
        if (l == DEPTH - 1 && bx == 0 && tid == 0) { STAMP(5);
            const float f1 = (float)pT1 / (float)ptot, f2 = (float)pT2 / (float)ptot; const float V = floorf(f1 * 64.f) * (1.f / 64.f) + f2 * (1.f / 64.f);
            __hip_atomic_store((float*)(barw + 8), V, __ATOMIC_RELAXED, __HIP_MEMORY_SCOPE_AGENT); }
#endif
        xcd_barrier(xbar, bar_nloc, bar_nx);
        STAMP(5);
    }
    {
    int tidf = threadIdx.x; asm volatile("" : "+v"(tidf));
    const int lane = tidf & 63, gw = bx * 8 + __builtin_amdgcn_readfirstlane(tidf >> 6);
    for (int row = gw; row < M_TOT; row += NGW) {
        float s = (lane < 16) ? ssq[(size_t)row * 16 + lane] : 0.f;
        s = wave_sum(s);
        const float rs = rsqrtf(s * (1.0f / D) + EPS);
        const bf16_t* xr = XB + (size_t)row * D; float* orow = out + (size_t)row * D;
#pragma unroll
        for (int j = 0; j < 4; ++j) { const u32x2 raw = *(const u32x2*)(xr + 4 * lane + 256 * j); const f32x4 gv = *(const f32x4*)(a.norm_final + 4 * lane + 256 * j);
            const f32x4 v = (f32x4){__uint_as_float(raw.x << 16), __uint_as_float(raw.x & 0xffff0000u), __uint_as_float(raw.y << 16), __uint_as_float(raw.y & 0xffff0000u)};
            f32x4 ov = v * rs * gv;
#if defined(PROBE_F1) || defined(PROBE_NA)
            { const float dl = sqrtf(__hip_atomic_load((float*)(barw + 8), __ATOMIC_RELAXED, __HIP_MEMORY_SCOPE_AGENT) * 4e-4f); ov += (f32x4){dl, -dl, dl, -dl}; }
#endif
            *(f32x4*)(orow + 4 * lane + 256 * j) = ov; }
    }
    }
}

extern "C" void kernel_launch(void* const* d_in, const int* in_sizes, int n_in, void* d_out, int out_size, void* d_ws, size_t ws_size, hipStream_t stream) {
    static int grid = 0;
    if (grid == 0) {
        if (n_in != 11 || out_size != M_TOT * D || ws_size < WS_END) { fprintf(stderr, "kernel_launch: unexpected shapes (n_in %d out %d ws %zu)\n", n_in, out_size, ws_size); grid = -1; return; }
        int dev = 0, cus = 0, per_cu = 0;
        hipGetDevice(&dev);
        hipDeviceGetAttribute(&cus, hipDeviceAttributeMultiprocessorCount, dev);
        hipFuncSetAttribute((const void*)mega_fwd, hipFuncAttributeMaxDynamicSharedMemorySize, LDS_BYTES);
        hipOccupancyMaxActiveBlocksPerMultiprocessor(&per_cu, (const void*)mega_fwd, 512, LDS_BYTES);
        if (per_cu < 1) { fprintf(stderr, "kernel_launch: occupancy query says %d blocks per CU\n", per_cu); per_cu = 1; }
        (void)hipGetLastError();
        grid = cus * 1;
    }
    if (grid < 0) return;
    Args a{};
    a.xp = (const float*)d_in[0]; a.xs = (const float*)d_in[1]; a.norm_mix = (const float*)d_in[2]; a.w_in = (const float*)d_in[3]; a.rpb = (const float*)d_in[4];
    a.sink = (const float*)d_in[5]; a.w_out = (const float*)d_in[6]; a.norm_mlp = (const float*)d_in[7]; a.w_up = (const float*)d_in[8]; a.w_down = (const float*)d_in[9];
    a.norm_final = (const float*)d_in[10]; a.out = (float*)d_out; a.ws = (unsigned char*)d_ws;
    for (int i = 0; i < 32; ++i) a.inv_freq[i] = (float)pow(10000.0, -(double)i / 32.0);
    void* args[] = {&a};
    hipError_t e = hipLaunchCooperativeKernel((const void*)mega_fwd, dim3(grid), dim3(512), args, LDS_BYTES, stream);
    if (e != hipSuccess) fprintf(stderr, "kernel_launch: cooperative launch failed: %s (grid %d)\n", hipGetErrorString(e), grid);
}
```

```cpp
#include <hip/hip_runtime.h>
#include <hip/hip_cooperative_groups.h>
#include <cstdio>
#include <cstdint>
#include <cmath>
namespace cg = cooperative_groups;

#define LAS __attribute__((address_space(3)))
typedef unsigned short bf16_t;
typedef short bf16x8 __attribute__((ext_vector_type(8)));
typedef short s16x4 __attribute__((ext_vector_type(4)));
typedef float f32x4 __attribute__((ext_vector_type(4)));
typedef float f32x2 __attribute__((ext_vector_type(2)));
typedef unsigned u32x4 __attribute__((ext_vector_type(4)));
typedef unsigned u32x2 __attribute__((ext_vector_type(2)));
typedef __bf16 bf16x2_t __attribute__((ext_vector_type(2)));

constexpr int D = 1024, DEPTH = 4, NIN = 2304, FF = 4096;
constexpr int M_TOT = 49152, M_SPLIT = 16384;
constexpr int NCHUNK = 2, CHUNK_ROWS = M_TOT / NCHUNK;
constexpr float EPS = 1e-5f;
constexpr float LOG2E = 1.4426950408889634f;
constexpr float QSCALE = 0.125f * LOG2E;
constexpr int C_QA = 0, C_QS = 512, C_KA = 1024, C_VA = 1536, C_KS = 2048, C_VS = 2176;
constexpr int G_QA = 0, G_QS = 8, G_KA = 16, G_VA = 24, G_KS = 32, G_VS = 34;
constexpr size_t GSTRIDE = (size_t)49152 * 64;

constexpr size_t MiB = 1u << 20;
constexpr size_t WS_ROPE = 1 * MiB;
constexpr size_t WS_SSQ = 5 * MiB;
constexpr size_t WS_WIN = 8 * MiB;
constexpr size_t WS_WOUT = 26 * MiB;
constexpr size_t WS_WUP = 34 * MiB;
constexpr size_t WS_WDN = 66 * MiB;
constexpr size_t WS_XB = 98 * MiB;
constexpr size_t WS_QKV = 194 * MiB;
constexpr size_t WS_H = 194 * MiB;
constexpr size_t WS_END = 410 * MiB;

constexpr int KROW = 144;
constexpr int LDS_KS = 0, LDS_VS = 512 * KROW, LDS_BIAS = 2 * 512 * KROW, LDS_XM = LDS_BIAS + 2048, LDS_TOTAL = LDS_XM + 1024;
constexpr int LDS_SSQ = 131072;
constexpr int LDS_BYTES = 163840;

__device__ __forceinline__ unsigned cvtpk(float lo, float hi) { f32x2 v = {lo, hi}; bf16x2_t b = __builtin_convertvector(v, bf16x2_t); return __builtin_bit_cast(unsigned, b); }
__device__ __forceinline__ float quad_sum(float s) {
    const auto a = __builtin_amdgcn_permlane16_swap(__float_as_uint(s), __float_as_uint(s), false, false);
    const float t = __uint_as_float(a[0]) + __uint_as_float(a[1]);
    const auto b = __builtin_amdgcn_permlane32_swap(__float_as_uint(t), __float_as_uint(t), false, false);
    return __uint_as_float(b[0]) + __uint_as_float(b[1]);
}
__device__ __forceinline__ float quad_max(float s) {
    const auto a = __builtin_amdgcn_permlane16_swap(__float_as_uint(s), __float_as_uint(s), false, false);
    const float t = fmaxf(__uint_as_float(a[0]), __uint_as_float(a[1]));
    const auto b = __builtin_amdgcn_permlane32_swap(__float_as_uint(t), __float_as_uint(t), false, false);
    return fmaxf(__uint_as_float(b[0]), __uint_as_float(b[1]));
}
__device__ __forceinline__ float wave_sum(float v) {
#pragma unroll
    for (int o = 1; o < 64; o <<= 1) v += __shfl_xor(v, o);
    return v;
}

namespace pg8 {
constexpr int BM = 256, BK = 64, HALF = 128, HTB = HALF * BK * 2, STAGE_BYTES = 8 * HTB, NXCD = 8, WGM = 8;
__host__ __device__ __forceinline__ int lds_byte(int r, int c) { const int st = (r >> 4) * 2 + (c >> 5), rr = r & 15, cc = c & 31, ob = rr * 64 + cc * 2; return st * 1024 + (ob ^ (((ob >> 9) & 1) << 5)); }
__host__ __device__ __forceinline__ void stage_rc(int b, int& R, int& C) { const int st = b / 1024, sb = b % 1024, swz = sb ^ (((sb >> 9) & 1) << 5); R = (st >> 1) * 16 + swz / 64; C = (st & 1) * 32 + (swz % 64) / 2; }
__host__ __device__ __forceinline__ int perm32(int rho) { const int n = rho >> 4, i = rho & 15; return 8 * (i >> 2) + 4 * n + (i & 3); }

struct Unit { int pm, pn; };
struct Gemm { const bf16_t* A; const bf16_t* Bt; int M, N, K, lda, ldb; size_t kstepA, kstepB; const bf16_t* A2; int pm2; };

struct StaticOrder {
    int nM, nN, nwg, G, c;
    __device__ void init(int M, int N, int G_, int c_) { nM = M / BM; nN = N / BM; nwg = nM * nN; G = G_; c = c_; }
    __device__ bool next(int i, Unit& u) const {
        const long L = (long)i * G + c; if (L >= nwg) return false;
        int wgid = (int)L; { const int q = nwg / NXCD, r = nwg % NXCD, xcd = wgid % NXCD, off = wgid / NXCD; wgid = (xcd < r ? xcd * (q + 1) : r * (q + 1) + (xcd - r) * q) + off; }
        const int nig = WGM * nN, gid = wgid / nig, fm = gid * WGM, gsz = (nM - fm) < WGM ? (nM - fm) : WGM;
        u.pm = fm + ((wgid % nig) % gsz); u.pn = (wgid % nig) / gsz; return true;
    }
};

template <class Epi>
__device__ __forceinline__ void gemm_phase(LAS unsigned char* lds, const Gemm g, const StaticOrder& S, const Epi& E) {
    int tid = threadIdx.x; asm volatile("" : "+v"(tid));
    const int wid = __builtin_amdgcn_readfirstlane(tid >> 6), lane = tid & 63, wr = wid >> 2, wc = wid & 3, fr = lane & 15, fq = lane >> 4;
    const int K = g.K, nt = K / BK;
    unsigned voffA[2], voffB[2];
#pragma unroll
    for (int i = 0; i < 2; ++i) { int R, C; stage_rc(tid * 16 + i * 8192, R, C); const int Rb = Epi::PERM ? ((R & ~31) + perm32(R & 31)) : R;
        voffA[i] = (unsigned)(R * g.lda + C) * 2u; voffB[i] = (unsigned)(Rb * g.ldb + C) * 2u; }
    const size_t kstepA = g.kstepA, kstepB = g.kstepB;
    const size_t hstepA = (size_t)HALF * g.lda * 2, hstepB = (size_t)HALF * g.ldb * 2;
    const size_t tstepA = 2 * hstepA, tstepB = 2 * hstepB;
    const unsigned ldsw = (unsigned)wid * 1024u;
    const int aoff = lds_byte(wr * 64 + fr, fq * 8), boff = lds_byte(wc * 32 + fr, fq * 8);
#define PG8_SA(b, h) (((b) * 2 + (h)) * HTB)
#define PG8_SB(b, h) ((4 + (b) * 2 + (h)) * HTB)
#define PG8_STAGE(bufoff, gbase, voff) do { _Pragma("unroll") for (int _i = 0; _i < 2; ++_i) \
        __builtin_amdgcn_global_load_lds((const unsigned*)((const char*)(gbase) + (voff)[_i]), (LAS unsigned*)(lds + (bufoff) + ldsw + _i * 8192), 16, 0, 0); } while (0)
#define PG8_LDA(dst, b, h) do { _Pragma("unroll") for (int m = 0; m < 4; ++m) _Pragma("unroll") for (int k = 0; k < 2; ++k) dst[m][k] = *(const LAS bf16x8*)(lds + PG8_SA(b, h) + aoff + m * 2048 + k * 1024); } while (0)
#define PG8_LDB(dst, b, h) do { _Pragma("unroll") for (int n = 0; n < 2; ++n) _Pragma("unroll") for (int k = 0; k < 2; ++k) dst[n][k] = *(const LAS bf16x8*)(lds + PG8_SB(b, h) + boff + n * 2048 + k * 1024); } while (0)
#define PG8_MMA(ai, bj, At, Bt) do { __builtin_amdgcn_s_setprio(1); _Pragma("unroll") for (int m = 0; m < 4; ++m) _Pragma("unroll") for (int n = 0; n < 2; ++n) _Pragma("unroll") for (int k = 0; k < 2; ++k) \
        acc[ai][bj][m][n] = __builtin_amdgcn_mfma_f32_16x16x32_bf16(Bt[n][k], At[m][k], acc[ai][bj][m][n], 0, 0, 0); __builtin_amdgcn_s_setprio(0); } while (0)
#define PG8_WAIT_V(n) asm volatile("s_waitcnt vmcnt(" #n ")" ::: "memory")
#define PG8_WAIT_L(n) asm volatile("s_waitcnt lgkmcnt(" #n ")" ::: "memory")
#define PG8_BAR __builtin_amdgcn_s_barrier()
#define PG8_SCHED __builtin_amdgcn_sched_barrier(0)
    Unit cur, nxt; int ui = 0;
    if (!S.next(0, cur)) return;
    f32x4 acc[2][2][4][2];
#pragma unroll
    for (int a = 0; a < 2; ++a)
#pragma unroll
        for (int b = 0; b < 2; ++b)
#pragma unroll
            for (int m = 0; m < 4; ++m)
#pragma unroll
                for (int n = 0; n < 2; ++n) acc[a][b][m][n] = (f32x4){0.f, 0.f, 0.f, 0.f};
    bf16x8 At[4][2], B0[2][2], B1[2][2];
#define PG8_TILE_A(pm_) ((pm_) < g.pm2 ? (const char*)g.A + (size_t)(pm_) * tstepA : (const char*)g.A2 + (size_t)((pm_) - g.pm2) * tstepA)
    const char* cA = PG8_TILE_A(cur.pm); const char* cB = (const char*)g.Bt + (size_t)cur.pn * tstepB;
    E.prefetch(lds, cur, wid, lane);
    PG8_STAGE(PG8_SB(0, 0), cB, voffB); PG8_STAGE(PG8_SB(0, 1), cB + hstepB, voffB); PG8_STAGE(PG8_SA(0, 0), cA, voffA); PG8_STAGE(PG8_SA(0, 1), cA + hstepA, voffA);
    if (wr == 1) PG8_BAR;
    PG8_WAIT_V(2); PG8_BAR;
    PG8_STAGE(PG8_SB(1, 0), cB + kstepB, voffB); PG8_STAGE(PG8_SA(1, 0), cA + kstepA, voffA); PG8_STAGE(PG8_SB(1, 1), cB + hstepB + kstepB, voffB);
    PG8_WAIT_V(6); PG8_BAR;
    for (;;) {
        const bool has_next = S.next(ui + 1, nxt);
        const char* nA = has_next ? PG8_TILE_A(nxt.pm) : cA; const char* nB = has_next ? (const char*)g.Bt + (size_t)nxt.pn * tstepB : cB;
        for (int t = 0; t < nt; t += 2) {
            const bool last = (t == nt - 2);
            const char* a1 = cA + (size_t)(t + 1) * kstepA;
            const char* a2 = last ? nA : cA + (size_t)(t + 2) * kstepA; const char* b2 = last ? nB : cB + (size_t)(t + 2) * kstepB;
            const char* a3 = a2 + kstepA; const char* b3 = b2 + kstepB;
            PG8_LDB(B0, 0, 0); PG8_LDB(B1, 0, 1); PG8_SCHED; PG8_LDA(At, 0, 0); PG8_STAGE(PG8_SA(1, 1), a1 + hstepA, voffA);
            PG8_WAIT_V(8); PG8_WAIT_L(0); PG8_BAR; PG8_MMA(0, 0, At, B0); PG8_MMA(0, 1, At, B1); PG8_BAR; PG8_SCHED;
            PG8_LDA(At, 0, 1); PG8_STAGE(PG8_SB(0, 0), b2, voffB); PG8_STAGE(PG8_SB(0, 1), b2 + hstepB, voffB); PG8_STAGE(PG8_SA(0, 0), a2, voffA);
            PG8_WAIT_V(8); PG8_WAIT_L(0); PG8_BAR; PG8_MMA(1, 0, At, B0); PG8_MMA(1, 1, At, B1); PG8_BAR; PG8_SCHED;
            PG8_LDB(B0, 1, 0); PG8_LDB(B1, 1, 1); PG8_SCHED; PG8_LDA(At, 1, 0); PG8_STAGE(PG8_SA(0, 1), a2 + hstepA, voffA);
            PG8_WAIT_V(8); PG8_WAIT_L(0); PG8_BAR; PG8_MMA(0, 0, At, B0); PG8_MMA(0, 1, At, B1); PG8_BAR; PG8_SCHED;
            PG8_LDA(At, 1, 1); PG8_STAGE(PG8_SB(1, 0), b3, voffB); PG8_STAGE(PG8_SB(1, 1), b3 + hstepB, voffB); PG8_STAGE(PG8_SA(1, 0), a3, voffA);
            PG8_WAIT_V(8); PG8_WAIT_L(0); PG8_BAR; PG8_MMA(1, 0, At, B0); PG8_MMA(1, 1, At, B1); PG8_BAR; PG8_SCHED;
        }
        if (wr == 0) PG8_BAR;
        E(acc, cur, wr, wc, fr, fq, lds + (ui & 1) * 16384);
        if (!has_next) break;
#pragma unroll
        for (int a = 0; a < 2; ++a)
#pragma unroll
            for (int b = 0; b < 2; ++b)
#pragma unroll
                for (int m = 0; m < 4; ++m)
#pragma unroll
                    for (int n = 0; n < 2; ++n) acc[a][b][m][n] = (f32x4){0.f, 0.f, 0.f, 0.f};
        cur = nxt; cA = nA; cB = nB; ++ui;
        if (Epi::HAS_PREFETCH) E.prefetch(lds + (ui & 1) * 16384, cur, wid, lane);
        if (wr == 1) PG8_BAR;
    }
    PG8_WAIT_V(0);
    PG8_BAR;
#undef PG8_TILE_A
#undef PG8_SA
#undef PG8_SB
#undef PG8_STAGE
#undef PG8_LDA
#undef PG8_LDB
#undef PG8_MMA
#undef PG8_WAIT_V
#undef PG8_WAIT_L
#undef PG8_BAR
#undef PG8_SCHED
}
}

__device__ __forceinline__ void ssq_prefetch(LAS unsigned char* lds, const float* ssq, int row0, int wid_unused, int lane_unused) {
    int t2 = threadIdx.x; asm volatile("" : "+v"(t2));
    const int w2 = __builtin_amdgcn_readfirstlane(t2 >> 6), l2 = t2 & 63;
    (void)wid_unused; (void)lane_unused; (void)ssq;
    const float* ssq_k = (const float*)(*(unsigned char* const*)((const char*)__builtin_amdgcn_kernarg_segment_ptr() + 96) + WS_SSQ);
#pragma unroll
    for (int i = 0; i < 2; ++i)
        __builtin_amdgcn_global_load_lds((const unsigned*)((const char*)(ssq_k + (size_t)row0 * 16) + (w2 * 2 + i) * 1024 + l2 * 16), (LAS unsigned*)(lds + LDS_SSQ + (w2 * 2 + i) * 1024), 16, 0, 0);
}
__device__ __forceinline__ void rows_rstd(float (&rs)[2][4], LAS unsigned char* lds, int rowloc, int fq) {
#pragma unroll
    for (int ai = 0; ai < 2; ++ai) {
        f32x4 sp[4];
#pragma unroll
        for (int m = 0; m < 4; ++m) sp[m] = *(const LAS f32x4*)(lds + LDS_SSQ + ((rowloc + ai * 128 + m * 16) * 16 + fq * 4) * 4);
#pragma unroll
        for (int m = 0; m < 4; ++m) { float s = quad_sum((sp[m].x + sp[m].y) + (sp[m].z + sp[m].w)); rs[ai][m] = rsqrtf(s * (1.0f / D) + EPS); }
    }
}
struct EpiQKV {
    static constexpr bool PERM = true, HAS_PREFETCH = true;
    bf16_t* O; const f32x4* rope;
    __device__ __forceinline__ void prefetch(LAS unsigned char* l, const pg8::Unit& u, int wid, int lane) const { ssq_prefetch(l, nullptr, u.pm * 256, wid, lane); }
    __device__ __forceinline__ void operator()(const f32x4 (&acc)[2][2][4][2], const pg8::Unit& u, int wr, int wc, int fr, int fq, LAS unsigned char* lds) const {
        const int pn = u.pn;
        const float qs = (pn < 4) ? QSCALE : 1.f;
        const int col0 = pn * 256 + wc * 32 + 8 * fq;
        const int i0h = 8 * (wc & 1) + 2 * fq;
        const int rowbase = u.pm * 256 + wr * 64 + fr;
        float rs[2][4]; rows_rstd(rs, lds, wr * 64 + fr, fq);
        const bool rope0 = (pn == 2) || (pn == 3) || (pn == 8), rope1 = (pn == 2) || (pn == 3);
#pragma unroll
        for (int ai = 0; ai < 2; ++ai)
#pragma unroll
          for (int mh = 0; mh < 2; ++mh) {
            f32x4 r0[2], r1[2];
            if (rope0) {
#pragma unroll
                for (int mm = 0; mm < 2; ++mm) { const int row = rowbase + ai * 128 + (2 * mh + mm) * 16; const int pos = row < M_SPLIT ? (row & 8191) : (row & 16383);
                    const f32x4* rp = rope + (size_t)pos * 16 + i0h; r0[mm] = rp[0]; r1[mm] = rp[1]; }
            }
#pragma unroll
            for (int mm = 0; mm < 2; ++mm) {
                const int m = 2 * mh + mm;
                const int row = rowbase + ai * 128 + m * 16;
                const float rsc = rs[ai][m] * qs;
                bf16_t* rowp = O + (size_t)(col0 >> 6) * GSTRIDE + (size_t)row * 64 + (col0 & 63);
#pragma unroll
                for (int bj = 0; bj < 2; ++bj) {
                    f32x4 v0 = acc[ai][bj][m][0] * rsc, v1 = acc[ai][bj][m][1] * rsc;
                    if (bj == 0 ? rope0 : rope1) {
                        const f32x4 a0 = r0[mm], a1 = r1[mm];
                        v0 = (f32x4){v0.x * a0.x - v0.y * a0.y, v0.y * a0.x + v0.x * a0.y, v0.z * a0.z - v0.w * a0.w, v0.w * a0.z + v0.z * a0.w};
                        v1 = (f32x4){v1.x * a1.x - v1.y * a1.y, v1.y * a1.x + v1.x * a1.y, v1.z * a1.z - v1.w * a1.w, v1.w * a1.z + v1.z * a1.w};
                    }
                    u32x4 w; w.x = cvtpk(v0.x, v0.y); w.y = cvtpk(v0.z, v0.w); w.z = cvtpk(v1.x, v1.y); w.w = cvtpk(v1.z, v1.w);
                    *(u32x4*)(rowp + bj * 2 * GSTRIDE) = w;
                }
            }
          }
    }
};
struct EpiUp {
    static constexpr bool PERM = true, HAS_PREFETCH = true;
    bf16_t* O; bf16_t* O2;
    __device__ __forceinline__ void prefetch(LAS unsigned char* l, const pg8::Unit& u, int wid, int lane) const { ssq_prefetch(l, nullptr, u.pm * 256, wid, lane); }
    __device__ __forceinline__ void operator()(const f32x4 (&acc)[2][2][4][2], const pg8::Unit& u, int wr, int wc, int fr, int fq, LAS unsigned char* lds) const {
        const int col0 = u.pn * 256 + wc * 32 + 8 * fq;
        const int rowbase = u.pm * 256 + wr * 64 + fr;
        float rs[2][4]; rows_rstd(rs, lds, wr * 64 + fr, fq);
        bf16_t* obase = (u.pm < CHUNK_ROWS / 256) ? O : O2 - (size_t)CHUNK_ROWS * FF;
#pragma unroll
        for (int ai = 0; ai < 2; ++ai)
#pragma unroll
            for (int m = 0; m < 4; ++m) {
                const int rl = rowbase + ai * 128 + m * 16;
                const float rsc = rs[ai][m];
                bf16_t* rowp = obase + (size_t)rl * FF + col0;
#pragma unroll
                for (int bj = 0; bj < 2; ++bj) {
                    f32x4 v0 = acc[ai][bj][m][0] * rsc, v1 = acc[ai][bj][m][1] * rsc;
                    v0 = __builtin_elementwise_max(v0, (f32x4){0.f, 0.f, 0.f, 0.f}); v1 = __builtin_elementwise_max(v1, (f32x4){0.f, 0.f, 0.f, 0.f});
                    v0 = v0 * v0; v1 = v1 * v1;
                    u32x4 w; w.x = cvtpk(v0.x, v0.y); w.y = cvtpk(v0.z, v0.w); w.z = cvtpk(v1.x, v1.y); w.w = cvtpk(v1.z, v1.w);
                    __builtin_nontemporal_store(w, (u32x4*)(rowp + bj * 128));
                }
            }
    }
};
struct EpiRes {
    static constexpr bool PERM = true, HAS_PREFETCH = false;
    bf16_t* xb; float* ssq; int row0;
    __device__ __forceinline__ void prefetch(LAS unsigned char*, const pg8::Unit&, int, int) const {}
    __device__ __forceinline__ void operator()(const f32x4 (&acc)[2][2][4][2], const pg8::Unit& u, int wr, int wc, int fr, int fq, LAS unsigned char* lds) const {
        const int col0 = u.pn * 256 + wc * 32 + 8 * fq;
        const int rowbase = row0 + u.pm * 256 + wr * 64 + fr;
        u32x4 raw[2][2][2];
#define ERES_LOAD(slot, hb) do { _Pragma("unroll") for (int mm = 0; mm < 2; ++mm) _Pragma("unroll") for (int bj = 0; bj < 2; ++bj) \
            raw[slot][mm][bj] = *(const u32x4*)(xb + (size_t)(rowbase + ((hb) >> 1) * 128 + (2 * ((hb) & 1) + mm) * 16) * D + col0 + bj * 128); } while (0)
        ERES_LOAD(0, 0); ERES_LOAD(1, 1);
#pragma unroll
        for (int hb = 0; hb < 4; ++hb) {
            const int ai = hb >> 1, mh = hb & 1, slot = hb & 1;
#pragma unroll
            for (int mm = 0; mm < 2; ++mm) {
                const int m = 2 * mh + mm;
                const int row = rowbase + ai * 128 + m * 16;
                bf16_t* xp = xb + (size_t)row * D + col0;
                float s = 0.f;
#pragma unroll
                for (int bj = 0; bj < 2; ++bj) {
                    const u32x4 rw = raw[slot][mm][bj];
                    const f32x4 a0 = acc[ai][bj][m][0], a1 = acc[ai][bj][m][1];
                    u32x4 w;
                    w.x = cvtpk(__uint_as_float(rw.x << 16) + a0.x, __uint_as_float(rw.x & 0xffff0000u) + a0.y);
                    w.y = cvtpk(__uint_as_float(rw.y << 16) + a0.z, __uint_as_float(rw.y & 0xffff0000u) + a0.w);
                    w.z = cvtpk(__uint_as_float(rw.z << 16) + a1.x, __uint_as_float(rw.z & 0xffff0000u) + a1.y);
                    w.w = cvtpk(__uint_as_float(rw.w << 16) + a1.z, __uint_as_float(rw.w & 0xffff0000u) + a1.w);
                    *(u32x4*)(xp + bj * 128) = w;
#pragma unroll
                    for (int e = 0; e < 4; ++e) { const float lo = __uint_as_float(w[e] << 16), hi = __uint_as_float(w[e] & 0xffff0000u); s += lo * lo + hi * hi; }
                }
                s = quad_sum(s);
                if (fq == 0) ssq[(size_t)row * 16 + u.pn * 4 + wc] = s;
            }
            if (hb + 2 < 4) { if (slot == 0) ERES_LOAD(0, hb + 2); else ERES_LOAD(1, hb + 2); }
        }
#undef ERES_LOAD
    }
};

__device__ __forceinline__ f32x4 mfma16(bf16x8 a, bf16x8 b, f32x4 c) { return __builtin_amdgcn_mfma_f32_16x16x32_bf16(a, b, c, 0, 0, 0); }
typedef short v4i16_t __attribute__((ext_vector_type(4)));
__device__ __forceinline__ s16x4 tr_read(LAS unsigned char* p) { return __builtin_bit_cast(s16x4, __builtin_amdgcn_ds_read_tr16_b64_v4i16((LAS v4i16_t*)p)); }
__device__ __forceinline__ bf16x8 pack_p(const f32x4& a, const f32x4& b) {
    u32x4 w; w.x = cvtpk(a.x, a.y); w.y = cvtpk(a.z, a.w); w.z = cvtpk(b.x, b.y); w.w = cvtpk(b.z, b.w); return __builtin_bit_cast(bf16x8, w);
}
__device__ __forceinline__ void pv_pair(f32x4 (&o)[4], LAS unsigned char* vaddr, bf16x8 pf) {
#pragma unroll
    for (int db = 0; db < 4; ++db) {
        const s16x4 a = tr_read(vaddr + db * 32), b = tr_read(vaddr + 16 * KROW + db * 32);
        const bf16x8 vf = (bf16x8){a[0], a[1], a[2], a[3], b[0], b[1], b[2], b[3]};
        o[db] = mfma16(vf, pf, o[db]);
    }
}

struct VFrag { s16x4 a[4], b[4]; };
__device__ __forceinline__ void vfrag_load(VFrag& F, LAS unsigned char* va, const int (&off)[4], int blk2) {
#pragma unroll
    for (int db = 0; db < 4; ++db) { F.a[db] = tr_read(va + off[db]); F.b[db] = tr_read(va + blk2 + off[db]); }
}
__device__ __forceinline__ void vfrag_mma(f32x4 (&o)[4], const VFrag& F, bf16x8 pf) {
#pragma unroll
    for (int db = 0; db < 4; ++db) { const bf16x8 vf = (bf16x8){F.a[db][0], F.a[db][1], F.a[db][2], F.a[db][3], F.b[db][0], F.b[db][1], F.b[db][2], F.b[db][3]}; o[db] = mfma16(vf, pf, o[db]); }
}
struct NaPre { u32x4 k[2], v[2]; bf16x8 q0, q1; };
__device__ __forceinline__ int na_rs(int g) {
    const int glo = g < 128 ? 0 : (g < 256 ? 128 : (g < 512 ? 256 : 512));
    const int rows = g < 256 ? 128 : 256;
    int rs = g - 4; rs = rs < glo ? glo : rs; rs = rs > glo + rows - 8 ? glo + rows - 8 : rs;
    return rs;
}
__device__ __forceinline__ int na_tokmax(int g) { const int glo = g < 128 ? 0 : (g < 256 ? 128 : (g < 512 ? 256 : 512)), rows = g < 256 ? 128 : 256; return 64 * (glo + rows) - 1; }
__device__ __forceinline__ void na_load_q(NaPre& P, const bf16_t* QKV, int p, int tid) {
    const int h = p / 384, g0 = 2 * (p % 384);
    const int lane = tid & 63, w = tid >> 6, n = lane & 15, q4 = lane >> 4;
    const bf16_t* qp = QKV + (size_t)(G_QA + h) * GSTRIDE + ((size_t)(g0 + (w >> 2)) * 64 + 16 * (w & 3) + n) * 64;
    P.q0 = *(const bf16x8*)(qp + 8 * q4); P.q1 = *(const bf16x8*)(qp + 32 + 8 * q4);
}
__device__ __forceinline__ void na_load_rows(NaPre& P, const bf16_t* QKV, int h, int r0, int tokmax, int tid) {
    const bf16_t* kb = QKV + (size_t)(G_KA + h) * GSTRIDE;
#pragma unroll
    for (int i = 0; i < 2; ++i) { int tok = 64 * (r0 + i) + (tid >> 3); tok = tok > tokmax ? tokmax : tok;
        const bf16_t* p = kb + (size_t)tok * 64 + (tid & 7) * 8; P.k[i] = *(const u32x4*)p; P.v[i] = *(const u32x4*)(p + (G_VA - G_KA) * GSTRIDE); }
}
__device__ __forceinline__ void na_phase(LAS unsigned char* lds, bf16_t* QKV, const float* rpb_l, int G, int vcu, unsigned* probe_words) {
    int tid = threadIdx.x; asm volatile("" : "+v"(tid));
    const int lane = tid & 63, w = __builtin_amdgcn_readfirstlane(tid >> 6), n = lane & 15, q4 = lane >> 4;
    constexpr int NP = 3072;
    const int ppc = (NP + G - 1) / G, pbeg = vcu * ppc, pend = (pbeg + ppc) < NP ? (pbeg + ppc) : NP;
    if (pbeg >= pend) return;
    LAS float* bias = (LAS float*)(lds + LDS_BIAS);
    const int jc = w & 3, wrow = w >> 2;
    const int cb = jc == 0 ? 0 : (jc == 1 ? 8 : (jc == 2 ? 24 : 32));
    const int c = 16 * jc + n; int cs = c - 8; cs = cs < 0 ? 0 : cs; cs = cs > 48 ? 48 : cs;
    const int sw0 = ((q4) ^ (n & 7)) << 4, sw1 = ((4 + q4) ^ (n & 7)) << 4;
    const int rr = (4 * (q4 & 1) + (n >> 2)), pp = n & 3;
    int voff[4];
#pragma unroll
    for (int db = 0; db < 4; ++db) voff[db] = (((2 * db + (pp >> 1)) ^ rr) << 4) + (pp & 1) * 8;
    bool sel[4]; int coff[4]; unsigned m01 = 0u, m23 = 0u;
#pragma unroll
    for (int i = 0; i < 4; ++i) { const int kc0 = cb + 4 * q4 + i; sel[i] = (kc0 >= cs) && (kc0 < cs + 16); coff[i] = (sel[i] ? kc0 : kc0 + 16) - c + 15; }
    m01 = (sel[0] ? 0x0000ffffu : 0u) | (sel[1] ? 0xffff0000u : 0u); m23 = (sel[2] ? 0x0000ffffu : 0u) | (sel[3] ? 0xffff0000u : 0u);
    const int wtok = tid >> 3, wch = tid & 7, woff = wtok * 128 + ((wch ^ (wtok & 7)) << 4);
    NaPre P; na_load_q(P, QKV, pbeg, tid);
    int have_h = -1, have_lo = -100000;
    float bc[8][4]; int bc_key = -1000000;
#pragma unroll
    for (int j = 0; j < 8; ++j)
#pragma unroll
        for (int i = 0; i < 4; ++i) bc[j][i] = 0.f;
#ifdef PROBE_NA
    unsigned nt_prev = (unsigned)__builtin_amdgcn_s_memrealtime(), nA = 0u, nB = 0u, nC = 0u;
#define NSTAMP(x) do { const unsigned now_ = (unsigned)__builtin_amdgcn_s_memrealtime(); x += now_ - nt_prev; nt_prev = now_; } while (0)
#else
#define NSTAMP(x) do { } while (0)
#endif
    for (int p = pbeg; p < pend; ++p) {
        const int h = p / 384, g0 = 2 * (p % 384), g = g0 + wrow;
        const int rs0 = na_rs(g0), rsw = na_rs(g), tokmax = na_tokmax(g0);
        const int adv = rs0 - have_lo;
        if (h != have_h || adv < 0 || adv > 2) {
            const bf16_t* kb = QKV + (size_t)(G_KA + h) * GSTRIDE;
            u32x4 kr[9], vr[9];
#pragma unroll
            for (int i = 0; i < 9; ++i) { int tok = 64 * (rs0 + i) + wtok; tok = tok > tokmax ? tokmax : tok;
                const bf16_t* q = kb + (size_t)tok * 64 + wch * 8; kr[i] = *(const u32x4*)q; vr[i] = *(const u32x4*)(q + (G_VA - G_KA) * GSTRIDE); }
            if (h != have_h && tid < 465) bias[tid] = rpb_l[h * 465 + tid] * LOG2E;
#pragma unroll
            for (int i = 0; i < 9; ++i) { const int slot = (rs0 + i) % 9;
                *(LAS u32x4*)(lds + LDS_KS + slot * 8192 + woff) = kr[i]; *(LAS u32x4*)(lds + LDS_VS + slot * 8192 + woff) = vr[i]; }
        } else {
            if (adv >= 1) { const int slot = (have_lo + 9) % 9; *(LAS u32x4*)(lds + LDS_KS + slot * 8192 + woff) = P.k[0]; *(LAS u32x4*)(lds + LDS_VS + slot * 8192 + woff) = P.v[0]; }
            if (adv == 2) { const int slot = (have_lo + 10) % 9; *(LAS u32x4*)(lds + LDS_KS + slot * 8192 + woff) = P.k[1]; *(LAS u32x4*)(lds + LDS_VS + slot * 8192 + woff) = P.v[1]; }
        }
        have_h = h; have_lo = rs0;
        const bf16x8 qf0 = P.q0, qf1 = P.q1;
        __syncthreads();
        NSTAMP(nA);
        if (p + 1 < pend) { na_load_rows(P, QKV, h, rs0 + 9, tokmax, tid); na_load_q(P, QKV, p + 1, tid); }
        int sl[8];
        { const int b9 = rsw % 9;
#pragma unroll
          for (int j = 0; j < 8; ++j) { const int t = b9 + j; sl[j] = (t >= 9 ? t - 9 : t) * 8192; } }
        f32x4 s[8][2];
        {
            const LAS unsigned char* kb0 = lds + LDS_KS + (cb + n) * 128;
            bf16x8 kf[2][4][2];
#pragma unroll
            for (int tt = 0; tt < 4; ++tt) { const LAS unsigned char* kp = kb0 + sl[tt >> 1] + 16 * (tt & 1) * 128; kf[0][tt][0] = *(const LAS bf16x8*)(kp + sw0); kf[0][tt][1] = *(const LAS bf16x8*)(kp + sw1); }
#pragma unroll
            for (int c = 0; c < 4; ++c) {
                if (c + 1 < 4) {
#pragma unroll
                    for (int tt = 0; tt < 4; ++tt) { const LAS unsigned char* kp = kb0 + sl[2 * (c + 1) + (tt >> 1)] + 16 * (tt & 1) * 128;
                        kf[(c + 1) & 1][tt][0] = *(const LAS bf16x8*)(kp + sw0); kf[(c + 1) & 1][tt][1] = *(const LAS bf16x8*)(kp + sw1); }
                }
                __builtin_amdgcn_sched_barrier(0);
                f32x4 z[4];
#pragma unroll
                for (int tt = 0; tt < 4; ++tt) z[tt] = mfma16(kf[c & 1][tt][0], qf0, (f32x4){0.f, 0.f, 0.f, 0.f});
#pragma unroll
                for (int tt = 0; tt < 4; ++tt) z[tt] = mfma16(kf[c & 1][tt][1], qf1, z[tt]);
#pragma unroll
                for (int tt = 0; tt < 4; ++tt) s[2 * c + (tt >> 1)][tt & 1] = z[tt];
                __builtin_amdgcn_sched_barrier(0);
            }
        }
        const int bkey = (rsw - g) + 64 * h;
        if (bkey != bc_key) {
#pragma unroll
            for (int j = 0; j < 8; ++j)
#pragma unroll
                for (int i = 0; i < 4; ++i) bc[j][i] = bias[(rsw + j - g + 7) * 31 + coff[i]];
            bc_key = bkey;
        }
        f32x4 sm[8];
        float mx = -1e30f;
#pragma unroll
        for (int j = 0; j < 8; ++j)
#pragma unroll
            for (int i = 0; i < 4; ++i) {
                const float v = (sel[i] ? s[j][0][i] : s[j][1][i]) + bc[j][i];
                sm[j][i] = v; mx = fmaxf(mx, v);
            }
        mx = quad_max(mx);
        NSTAMP(nB);
        float l = 0.f;
#pragma unroll
        for (int j = 0; j < 8; ++j)
#pragma unroll
            for (int i = 0; i < 4; ++i) { const float pe = __builtin_amdgcn_exp2f(sm[j][i] - mx); sm[j][i] = pe; l += pe; }
        l = quad_sum(l);
        f32x4 o[4];
#pragma unroll
        for (int db = 0; db < 4; ++db) o[db] = (f32x4){0.f, 0.f, 0.f, 0.f};
        {
            LAS unsigned char* vbase = lds + LDS_VS + (cb + 4 * q4 + (n >> 2)) * 128;
            VFrag F0, F1; vfrag_load(F0, vbase + sl[0], voff, 16 * 128);
#pragma unroll
            for (int j = 0; j < 8; ++j) {
                if (j + 1 < 8) { if ((j & 1) == 0) vfrag_load(F1, vbase + sl[j + 1], voff, 16 * 128); else vfrag_load(F0, vbase + sl[j + 1], voff, 16 * 128); }
                const unsigned p01 = cvtpk(sm[j][0], sm[j][1]), p23 = cvtpk(sm[j][2], sm[j][3]);
                u32x4 pw; pw.x = p01 & m01; pw.y = p23 & m23; pw.z = p01 & ~m01; pw.w = p23 & ~m23;
                const bf16x8 pf = __builtin_bit_cast(bf16x8, pw);
                if ((j & 1) == 0) vfrag_mma(o, F0, pf); else vfrag_mma(o, F1, pf);
            }
        }
        const float inv = 1.0f / l;
        bf16_t* qp = QKV + (size_t)(G_QA + h) * GSTRIDE + ((size_t)g * 64 + 16 * jc + n) * 64;
#pragma unroll
        for (int db = 0; db < 4; ++db) {
            const f32x4 v = o[db] * inv;
            u32x2 wv; wv.x = cvtpk(v.x, v.y); wv.y = cvtpk(v.z, v.w);
            *(u32x2*)(qp + 16 * db + 4 * q4) = wv;
        }
        __syncthreads();
        NSTAMP(nC);
    }
#ifdef PROBE_NA
    if (blockIdx.x == 0 && tid == 0) { unsigned* bw = (unsigned*)probe_words; atomicAdd(bw + 10, nA); atomicAdd(bw + 11, nB); atomicAdd(bw + 12, nC); }
#endif
}

constexpr int SWA_KEYS = 336;
struct SwaPre { u32x4 k[6], v[6]; bf16x8 q[2][2]; float sink; };
__device__ __forceinline__ void swa_issue(SwaPre& P, const bf16_t* QKV, const float* sink_l, int u, int tid) {
    const int kvh = u / 768, P0 = 64 * (u % 768);
    const int slo = P0 < 8192 ? 0 : (P0 < 16384 ? 8192 : (P0 < 32768 ? 16384 : 32768));
    const int shi = P0 < 8192 ? 8192 : (P0 < 16384 ? 16384 : (P0 < 32768 ? 32768 : 49152));
#pragma unroll
    for (int i = 0; i < 6; ++i) { const int idx = tid + 512 * i, kidx = idx >> 3, ch = idx & 7; const int tok = P0 - 128 + kidx;
        const bool ok = (idx < SWA_KEYS * 8) && tok >= slo && tok < shi;
        const bf16_t* p = QKV + (size_t)(G_KS + kvh) * GSTRIDE + (size_t)(ok ? tok : P0) * 64 + ch * 8;
        P.k[i] = *(const u32x4*)p; P.v[i] = *(const u32x4*)(p + (G_VS - G_KS) * GSTRIDE); }
    const int lane = tid & 63, w = tid >> 6, n = lane & 15, q4 = lane >> 4;
#pragma unroll
    for (int sub = 0; sub < 2; ++sub) {
        const bf16_t* qp = QKV + (size_t)(G_QS + 4 * kvh + (w & 3)) * GSTRIDE + (size_t)(P0 + 16 * ((w >> 2) + 2 * sub) + n) * 64;
        P.q[sub][0] = *(const bf16x8*)(qp + 8 * q4); P.q[sub][1] = *(const bf16x8*)(qp + 32 + 8 * q4); }
    P.sink = sink_l[4 * kvh + (w & 3)];
}
__device__ __forceinline__ void swa_task(LAS unsigned char* lds, bf16_t* QKV, bf16x8 qf0, bf16x8 qf1, float sinkv, int hq, int P0, int pg, int slo, int shi, int n, int q4) {
    const int p0 = P0 + 16 * pg;
    f32x4 s[9][2];
    s[8][1] = (f32x4){-1e30f, -1e30f, -1e30f, -1e30f};
    {
        const LAS unsigned char* kb0 = lds + LDS_KS + (16 * pg + n) * KROW + q4 * 16;
        bf16x8 kf[2][4][2];
#pragma unroll
        for (int tt = 0; tt < 4; ++tt) { kf[0][tt][0] = *(const LAS bf16x8*)(kb0 + 16 * tt * KROW); kf[0][tt][1] = *(const LAS bf16x8*)(kb0 + 16 * tt * KROW + 64); }
#pragma unroll
        for (int c = 0; c < 5; ++c) {
            if (c + 1 < 5) {
#pragma unroll
                for (int tt = 0; tt < 4; ++tt) { const int tau = 4 * (c + 1) + tt;
                    if (tau < 17) { kf[(c + 1) & 1][tt][0] = *(const LAS bf16x8*)(kb0 + 16 * tau * KROW); kf[(c + 1) & 1][tt][1] = *(const LAS bf16x8*)(kb0 + 16 * tau * KROW + 64); } }
            }
            __builtin_amdgcn_sched_barrier(0);
            f32x4 z[4];
#pragma unroll
            for (int tt = 0; tt < 4; ++tt) if (4 * c + tt < 17) z[tt] = mfma16(kf[c & 1][tt][0], qf0, (f32x4){0.f, 0.f, 0.f, 0.f});
#pragma unroll
            for (int tt = 0; tt < 4; ++tt) if (4 * c + tt < 17) z[tt] = mfma16(kf[c & 1][tt][1], qf1, z[tt]);
#pragma unroll
            for (int tt = 0; tt < 4; ++tt) { const int tau = 4 * c + tt; if (tau < 17) s[tau >> 1][tau & 1] = z[tt]; }
            __builtin_amdgcn_sched_barrier(0);
        }
    }
    const bool edge = (p0 - 128 < slo) || (p0 + 144 > shi);
    if (__builtin_amdgcn_readfirstlane((int)edge)) {
#pragma unroll
        for (int j = 0; j < 9; ++j)
#pragma unroll
            for (int t = 0; t < 2; ++t)
#pragma unroll
                for (int i = 0; i < 4; ++i) { const int key = p0 - 128 + 32 * j + 16 * t + 4 * q4 + i; s[j][t][i] = (key >= slo && key < shi) ? s[j][t][i] : -1e30f; }
        asm volatile("" ::: "memory");
    }
    float mx = -1e30f;
#pragma unroll
    for (int j = 0; j < 9; ++j)
#pragma unroll
        for (int t = 0; t < 2; ++t)
#pragma unroll
            for (int i = 0; i < 4; ++i) {
                if (j == 8 && t == 1) continue;
                float v = s[j][t][i];
                if (j == 0 && t == 0) v = (4 * q4 + i < n) ? -1e30f : v;
                if (j == 8) v = (4 * q4 + i > n) ? -1e30f : v;
                s[j][t][i] = v; mx = fmaxf(mx, v);
            }
    mx = quad_max(mx);
    mx = fmaxf(mx, sinkv);
    float l = 0.f;
#pragma unroll
    for (int j = 0; j < 9; ++j)
#pragma unroll
        for (int t = 0; t < 2; ++t)
#pragma unroll
            for (int i = 0; i < 4; ++i) { if (j == 8 && t == 1) { s[j][t][i] = 0.f; continue; } const float p = __builtin_amdgcn_exp2f(s[j][t][i] - mx); s[j][t][i] = p; l += p; }
    l = quad_sum(l);
    l += __builtin_amdgcn_exp2f(sinkv - mx);
    f32x4 o[4];
#pragma unroll
    for (int db = 0; db < 4; ++db) o[db] = (f32x4){0.f, 0.f, 0.f, 0.f};
    {
        LAS unsigned char* vbase = lds + LDS_VS + (16 * pg + 4 * q4 + (n >> 2)) * KROW + (n & 3) * 8;
        const int voff4[4] = {0, 32, 64, 96};
        VFrag F0, F1; vfrag_load(F0, vbase, voff4, 16 * KROW);
#pragma unroll
        for (int j = 0; j < 9; ++j) {
            if (j + 1 < 9) { if ((j & 1) == 0) vfrag_load(F1, vbase + 32 * (j + 1) * KROW, voff4, 16 * KROW); else vfrag_load(F0, vbase + 32 * (j + 1) * KROW, voff4, 16 * KROW); }
            const bf16x8 pf = pack_p(s[j][0], s[j][1]);
            if ((j & 1) == 0) vfrag_mma(o, F0, pf); else vfrag_mma(o, F1, pf);
        }
    }
    const float inv = 1.0f / l;
    bf16_t* qp = QKV + (size_t)(G_QS + hq) * GSTRIDE + (size_t)(p0 + n) * 64;
#pragma unroll
    for (int db = 0; db < 4; ++db) {
        const f32x4 v = o[db] * inv;
        u32x2 wv; wv.x = cvtpk(v.x, v.y); wv.y = cvtpk(v.z, v.w);
        *(u32x2*)(qp + 16 * db + 4 * q4) = wv;
    }
}
__device__ __forceinline__ void swa_phase(LAS unsigned char* lds, bf16_t* QKV, const float* sink_l, int G, int bx) {
    int tid = threadIdx.x; asm volatile("" : "+v"(tid));
    const int lane = tid & 63, w = __builtin_amdgcn_readfirstlane(tid >> 6), n = lane & 15, q4 = lane >> 4;
    constexpr int NU = 1536;
    if (bx >= NU) return;
    SwaPre P; swa_issue(P, QKV, sink_l, bx, tid);
    for (int u = bx; u < NU; u += G) {
        const int kvh = u / 768, P0 = 64 * (u % 768);
        const int slo = P0 < 8192 ? 0 : (P0 < 16384 ? 8192 : (P0 < 32768 ? 16384 : 32768));
        const int shi = P0 < 8192 ? 8192 : (P0 < 16384 ? 16384 : (P0 < 32768 ? 32768 : 49152));
#pragma unroll
        for (int i = 0; i < 6; ++i) { const int idx = tid + 512 * i, kidx = idx >> 3, ch = idx & 7; const int tok = P0 - 128 + kidx; const bool ok = tok >= slo && tok < shi;
            const u32x4 z = (u32x4){0u, 0u, 0u, 0u};
            if (idx < SWA_KEYS * 8) { *(LAS u32x4*)(lds + LDS_KS + kidx * KROW + ch * 16) = ok ? P.k[i] : z; *(LAS u32x4*)(lds + LDS_VS + kidx * KROW + ch * 16) = ok ? P.v[i] : z; } }
        const float sinkv = P.sink * LOG2E;
        const int hq = 4 * kvh + (w & 3);
        __syncthreads();
        swa_task(lds, QKV, P.q[0][0], P.q[0][1], sinkv, hq, P0, (w >> 2), slo, shi, n, q4);
        const bf16x8 qb0 = P.q[1][0], qb1 = P.q[1][1];
        if (u + G < NU) swa_issue(P, QKV, sink_l, u + G, tid);
        swa_task(lds, QKV, qb0, qb1, sinkv, hq, P0, (w >> 2) + 2, slo, shi, n, q4);
        __syncthreads();
    }
}

__device__ __forceinline__ int win_src(int n) {
    if (n < 512) return n;
    if (n < 1024) { const int p = n - 512, pp = p & 63; return 1536 + (p & ~63) + (pp >> 1) + ((pp & 1) << 5); }
    if (n < 1536) return 512 + (n - 1024);
    if (n < 2048) return 1024 + (n - 1536);
    if (n < 2176) { const int p = n - 2048, pp = p & 63; return 2048 + (p & ~63) + (pp >> 1) + ((pp & 1) << 5); }
    return n;
}
struct TDesc { const float* W; bf16_t* WT; const float* gain; int K, N, k0, n0, src; };
struct TRegs { float wv[32]; f32x4 ga, gb; };
__device__ __forceinline__ void transpose_load(TRegs& R, const TDesc& d, int lane) {
    const int c = lane & 7;
    R.ga = (f32x4){1.f, 1.f, 1.f, 1.f}; R.gb = R.ga;
    if (d.gain) { R.ga = *(const f32x4*)(d.gain + d.k0 + 8 * c); R.gb = *(const f32x4*)(d.gain + d.k0 + 8 * c + 4); }
#pragma unroll
    for (int i = 0; i < 32; ++i) R.wv[i] = __builtin_nontemporal_load(d.W + (size_t)(d.k0 + 2 * i + (lane >> 5)) * d.N + d.src);
}
__device__ __forceinline__ void transpose_finish(const TRegs& R, const TDesc& d, LAS float* scr, int lane) {
    const int c = lane & 7;
#pragma unroll
    for (int i = 0; i < 32; ++i) scr[(2 * i + (lane >> 5)) * 33 + (lane & 31)] = R.wv[i];
    asm volatile("s_waitcnt lgkmcnt(0)" ::: "memory");
#pragma unroll
    for (int j = 0; j < 4; ++j) { const int n = (lane >> 3) + 8 * j; const LAS float* sp = scr + (8 * c) * 33 + n;
        u32x4 o; o.x = cvtpk(sp[0 * 33] * R.ga.x, sp[1 * 33] * R.ga.y); o.y = cvtpk(sp[2 * 33] * R.ga.z, sp[3 * 33] * R.ga.w); o.z = cvtpk(sp[4 * 33] * R.gb.x, sp[5 * 33] * R.gb.y); o.w = cvtpk(sp[6 * 33] * R.gb.z, sp[7 * 33] * R.gb.w);
        *(u32x4*)(d.WT + (size_t)(d.n0 + n) * d.K + d.k0 + 8 * c) = o; }
    asm volatile("s_waitcnt lgkmcnt(0)" ::: "memory");
}
__device__ __forceinline__ void sincos_acc(float ang, float& co, float& si) {
    const double a = (double)ang;
    const double q = __builtin_rint(a * 0.63661977236758134308);
    double r = __builtin_fma(-q, 1.57079632679489655800e+00, a); r = __builtin_fma(-q, 6.12323399573676603587e-17, r);
    const double r2 = r * r;
    double sp = -2.50521083854417187751e-08; sp = sp * r2 + 2.75573192239858906526e-06; sp = sp * r2 - 1.98412698412698412698e-04; sp = sp * r2 + 8.33333333333333333333e-03; sp = sp * r2 - 1.66666666666666666667e-01;
    const double sn = r + r * r2 * sp;
    double cp = 2.08767569878680989792e-09; cp = cp * r2 - 2.75573192239858906526e-07; cp = cp * r2 + 2.48015873015873015873e-05; cp = cp * r2 - 1.38888888888888888889e-03; cp = cp * r2 + 4.16666666666666666667e-02; cp = cp * r2 - 0.5;
    const double cn = 1.0 + r2 * cp;
    const int qi = ((int)q) & 3;
    const double c2 = (qi == 0) ? cn : (qi == 1) ? -sn : (qi == 2) ? -cn : sn;
    const double s2 = (qi == 0) ? sn : (qi == 1) ? cn : (qi == 2) ? -sn : -cn;
    co = (float)c2; si = (float)s2;
}

#define XB_TMO      128
#define XB_XCNT(j)  (256  + 64 * (j))
#define XB_XSUB(j)  (1280 + 64 * (j))
#define XB_XGEN(j)  (2304 + 64 * (j))
#define XB_TOP      3328
#define XB_TOPGEN   3392
#define XCD_BAR_WORDS 3456
#define XB_SPIN_CAP (1u << 18)
__device__ __forceinline__ unsigned xb_ld(unsigned* p)              { return __hip_atomic_load(p, __ATOMIC_RELAXED, __HIP_MEMORY_SCOPE_AGENT); }
__device__ __forceinline__ unsigned xb_add(unsigned* p, unsigned v) { return __hip_atomic_fetch_add(p, v, __ATOMIC_RELAXED, __HIP_MEMORY_SCOPE_AGENT); }
__device__ __forceinline__ unsigned xb_xcc_id() { return (unsigned)__builtin_amdgcn_s_getreg((3 << 11) | 20) & 0xFu; }
#define XB_SPIN(cond, bar) do { unsigned _sp = 0; while (cond) { __builtin_amdgcn_s_sleep(1); \
    if ((++_sp & 255u) == 0u) { if (xb_ld(&(bar)[XB_TMO])) break; if (_sp > XB_SPIN_CAP) { atomicAdd(&(bar)[XB_TMO], 1u); break; } } } } while (0)
struct XcdBarrier { unsigned* bar; unsigned x; unsigned* st; };
__device__ __forceinline__ XcdBarrier xcd_barrier_post(unsigned* bar, unsigned* st) {
    XcdBarrier b; b.bar = bar; b.x = xb_xcc_id(); b.st = st;
    if (threadIdx.x == 0) { (void)xb_add(&bar[XB_XCNT(b.x)], 1u);
    }
    return b;
}
__device__ __forceinline__ void xcd_barrier_complete(unsigned* bar, unsigned x, unsigned& nloc, unsigned& nx) {
    const unsigned G = gridDim.x * gridDim.y * gridDim.z;
    unsigned sum, cnt, mine, sp = 0u;
    for (;;) {
        sum = 0u; cnt = 0u; mine = 0u;
#pragma unroll
        for (unsigned j = 0; j < 16; ++j) { const unsigned c = xb_ld(&bar[XB_XCNT(j)]); sum += c; cnt += (c > 0u) ? 1u : 0u; mine = (j == x) ? c : mine; }
        if (sum == G) break;
        __builtin_amdgcn_s_sleep(1);
        if ((++sp & 255u) == 0u) { if (xb_ld(&bar[XB_TMO])) break; if (sp > XB_SPIN_CAP) { atomicAdd(&bar[XB_TMO], 1u); break; } }
    }
    nloc = mine > 0u ? mine : 1u; nx = cnt > 0u ? cnt : 1u;
}
__device__ __forceinline__ void xcd_barrier(const XcdBarrier& b, unsigned& nloc_s, unsigned& nx_s) {
    asm volatile("s_waitcnt vmcnt(0)" ::: "memory");
    __syncthreads();
    if (threadIdx.x == 0) {
        unsigned* bar = b.bar;
        __builtin_amdgcn_s_waitcnt(0);
        unsigned nloc = nloc_s, nx = nx_s;
        if (nloc == 0u) { xcd_barrier_complete(bar, b.x, nloc, nx); nloc_s = nloc; nx_s = nx; }
        const unsigned old = xb_add(&bar[XB_XSUB(b.x)], 1u);
        const unsigned gen = old / nloc;
        if (old + 1u == (gen + 1u) * nloc) {
            __builtin_amdgcn_fence(__ATOMIC_RELEASE, "agent");
            asm volatile("s_waitcnt vmcnt(0)" ::: "memory");
            const unsigned og = xb_add(&bar[XB_TOP], 1u);
            const unsigned tg = og / nx;
            if (og + 1u == (tg + 1u) * nx) xb_add(&bar[XB_TOPGEN], 1u);
            else XB_SPIN(xb_ld(&bar[XB_TOPGEN]) == tg, bar);
            __builtin_amdgcn_fence(__ATOMIC_ACQUIRE, "agent");
            xb_add(&bar[XB_XGEN(b.x)], 1u);
            asm volatile("s_waitcnt vmcnt(0)" ::: "memory");
        } else {
            XB_SPIN(xb_ld(&bar[XB_XGEN(b.x)]) == gen, bar);
            __builtin_amdgcn_fence(__ATOMIC_ACQUIRE, "agent");
            asm volatile("s_waitcnt vmcnt(0)" ::: "memory");
        }
    }
    nloc_s = __builtin_amdgcn_readfirstlane(nloc_s); nx_s = __builtin_amdgcn_readfirstlane(nx_s);
    __syncthreads();
}

struct Args {
    const float* xp; const float* xs; const float* norm_mix; const float* w_in; const float* rpb; const float* sink; const float* w_out;
    const float* norm_mlp; const float* w_up; const float* w_down; const float* norm_final;
    float* out; unsigned char* ws;
    float inv_freq[32];
};

static_assert(__builtin_offsetof(Args, ws) == 96, "ssq_prefetch reads Args::ws from the kernel-argument segment at byte 96");
__global__ void __launch_bounds__(512, 2) mega_fwd(Args a) {
    extern __shared__ __attribute__((aligned(16))) unsigned char lds_raw[];
    LAS unsigned char* lds = (LAS unsigned char*)lds_raw;
    cg::grid_group grid = cg::this_grid();
    const int tid = threadIdx.x, lane = tid & 63, wave = __builtin_amdgcn_readfirstlane(tid >> 6);
    const int G = gridDim.x, bx = blockIdx.x;
    const int gw = bx * 8 + wave, NGW = G * 8;
    unsigned char* ws = a.ws;
    float* rope = (float*)(ws + WS_ROPE); float* ssq = (float*)(ws + WS_SSQ);
    bf16_t* Win = (bf16_t*)(ws + WS_WIN); bf16_t* Wout = (bf16_t*)(ws + WS_WOUT); bf16_t* Wup = (bf16_t*)(ws + WS_WUP); bf16_t* Wdn = (bf16_t*)(ws + WS_WDN);
    bf16_t* XB = (bf16_t*)(ws + WS_XB); bf16_t* QKV = (bf16_t*)(ws + WS_QKV); bf16_t* HB = (bf16_t*)(ws + WS_H);
    float* out = a.out;
#ifdef PROBE_F1
    const unsigned pt_start = (unsigned)__builtin_amdgcn_s_memrealtime();
#endif
    unsigned* barw = (unsigned*)ws;
    if (bx == 0) for (int i = tid; i < XCD_BAR_WORDS + 2 * G; i += 512) barw[i] = 0u;
    unsigned* bst = barw + XCD_BAR_WORDS + 2 * bx;

    {
        LAS float* scr = (LAS float*)(lds + wave * 16384);
        constexpr int I_IN = (D / 64) * (NIN / 32), I_OUT = (D / 64) * (D / 32), I_UP = (D / 64) * (FF / 32), I_DN = (FF / 64) * (D / 32);
        constexpr int I_LAYER = I_IN + I_OUT + I_UP + I_DN;
        auto decode = [&](int it) -> TDesc {
            const int l = it / I_LAYER; int r = it % I_LAYER;
            TDesc d; bool inmap = false;
            if (r < I_IN) { d.W = a.w_in + (size_t)l * D * NIN; d.K = D; d.N = NIN; d.WT = Win + (size_t)l * NIN * D; d.gain = a.norm_mix + l * D; inmap = true; }
            else if ((r -= I_IN) < I_OUT) { d.W = a.w_out + (size_t)l * D * D; d.K = D; d.N = D; d.WT = Wout + (size_t)l * D * D; d.gain = nullptr; }
            else if ((r -= I_OUT) < I_UP) { d.W = a.w_up + (size_t)l * D * FF; d.K = D; d.N = FF; d.WT = Wup + (size_t)l * FF * D; d.gain = a.norm_mlp + l * D; }
            else { r -= I_UP; d.W = a.w_down + (size_t)l * FF * D; d.K = FF; d.N = D; d.WT = Wdn + (size_t)l * D * FF; d.gain = nullptr; }
            const int nblk = d.N / 32; d.k0 = 64 * (r / nblk); d.n0 = 32 * (r % nblk);
            const int nphys = d.n0 + (lane & 31); d.src = inmap ? win_src(nphys) : nphys;
            return d;
        };
        constexpr int I_TOT = DEPTH * I_LAYER;
        int it = gw;
        if (it < I_TOT) {
            TRegs RA, RB; TDesc dA = decode(it), dB = dA; transpose_load(RA, dA, lane);
            for (;;) {
                const int it1 = it + NGW; const bool h1 = it1 < I_TOT;
                if (h1) { dB = decode(it1); transpose_load(RB, dB, lane); }
                transpose_finish(RA, dA, scr, lane);
                if (!h1) break;
                const int it2 = it1 + NGW; const bool h2 = it2 < I_TOT;
                if (h2) { dA = decode(it2); transpose_load(RA, dA, lane); }
                transpose_finish(RB, dB, scr, lane);
                if (!h2) break;
                it = it2;
            }
        }
        for (int row = gw; row < M_TOT; row += NGW) {
            const float* xr = (row < M_SPLIT ? a.xp + (size_t)row * D : a.xs + (size_t)(row - M_SPLIT) * D);
            float s = 0.f;
#pragma unroll
            for (int j = 0; j < 4; ++j) { const f32x4 v = __builtin_nontemporal_load((const f32x4*)(xr + 4 * lane + 256 * j));
                u32x2 wv; wv.x = cvtpk(v.x, v.y); wv.y = cvtpk(v.z, v.w); *(u32x2*)(XB + (size_t)row * D + 4 * lane + 256 * j) = wv;
                const float r0 = __uint_as_float(wv.x << 16), r1 = __uint_as_float(wv.x & 0xffff0000u), r2 = __uint_as_float(wv.y << 16), r3 = __uint_as_float(wv.y & 0xffff0000u);
                s += (r0 * r0 + r1 * r1) + (r2 * r2 + r3 * r3); }
            s = wave_sum(s);
            if (lane < 16) ssq[(size_t)row * 16 + lane] = (lane == 0) ? s : 0.f;
        }
        for (int e = bx * 512 + tid; e < 16384 * 32; e += G * 512) {
            const int pos = e >> 5, i = e & 31; float co, si; sincos_acc((float)pos * a.inv_freq[i], co, si);
            rope[2 * e] = co; rope[2 * e + 1] = si;
        }
    }
    grid.sync();
    const XcdBarrier xbar = xcd_barrier_post(barw, bst);
    unsigned bar_nloc = 0u, bar_nx = 0u;
#ifdef PROBE_F1
    unsigned pt_prev = (unsigned)__builtin_amdgcn_s_memrealtime(), pT1 = 0u, pT2 = 0u, ptot = 0u;
    { const unsigned d0 = pt_prev - pt_start; ptot += d0; if (PROBE_F1 == 0) pT1 += d0; if (PROBE_F2 == 0) pT2 += d0; }
#define STAMP(cat) do { const unsigned now_ = (unsigned)__builtin_amdgcn_s_memrealtime(); const unsigned d_ = now_ - pt_prev; pt_prev = now_; ptot += d_; if ((cat) == PROBE_F1) pT1 += d_; if ((cat) == PROBE_F2) pT2 += d_; } while (0)
#else
#define STAMP(cat) do { } while (0)
#endif

    for (int l = 0; l < DEPTH; ++l) {
        {
            pg8::Gemm g{XB, Win + (size_t)l * NIN * D, M_TOT, NIN, D, D, D, 128, 128, XB, 1 << 30}; pg8::StaticOrder S; S.init(M_TOT, NIN, G, bx);
            EpiQKV E{QKV, (const f32x4*)rope};
#ifndef NO_G1
            pg8::gemm_phase<EpiQKV>(lds, g, S, E);
#endif
        }
        xcd_barrier(xbar, bar_nloc, bar_nx);
        STAMP(1);
        {
            const float* rpb_l = a.rpb + (size_t)l * 8 * 465; const float* sink_l = a.sink + l * 8;
            const int vcu = (G % 8 == 0) ? (bx % 8) * (G / 8) + bx / 8 : bx;
            na_phase(lds, QKV, rpb_l, G, vcu, barw);
            STAMP(2);
            swa_phase(lds, QKV, sink_l, G, vcu);
        }
        xcd_barrier(xbar, bar_nloc, bar_nx);
        STAMP(6);
        {
            pg8::Gemm g{QKV, Wout + (size_t)l * D * D, M_TOT, D, D, 64, D, (size_t)M_TOT * 128, 128, QKV, 1 << 30};
            pg8::StaticOrder S; S.init(M_TOT, D, G, bx);
            EpiRes E{XB, ssq, 0};
#ifndef NO_G2
            pg8::gemm_phase<EpiRes>(lds, g, S, E);
#endif
        }
        xcd_barrier(xbar, bar_nloc, bar_nx);
        STAMP(3);
        {
            pg8::Gemm g{XB, Wup + (size_t)l * FF * D, M_TOT, FF, D, D, D, 128, 128, XB, 1 << 30}; pg8::StaticOrder S; S.init(M_TOT, FF, G, bx);
            EpiUp E{HB, (bf16_t*)out};
#ifndef NO_G3
            pg8::gemm_phase<EpiUp>(lds, g, S, E);
#endif
        }
        xcd_barrier(xbar, bar_nloc, bar_nx);
        STAMP(4);
        {
            pg8::Gemm g{HB, Wdn + (size_t)l * D * FF, M_TOT, D, FF, FF, FF, 128, 128, (const bf16_t*)out, CHUNK_ROWS / 256}; pg8::StaticOrder S; S.init(M_TOT, D, G, bx);
            EpiRes E{XB, ssq, 0};
#ifndef NO_G4
            pg8::gemm_phase<EpiRes>(lds, g, S, E);
#endif
        }
#ifdef PROBE_NA
        if (l == DEPTH - 1 && bx == 0 && tid == 0) { const float tA = (float)xb_ld(barw + 10), tB = (float)xb_ld(barw + 11), tC = (float)xb_ld(barw + 12), tt = tA + tB + tC;
            const float V = floorf(tA / tt * 64.f) * (1.f / 64.f) + (tB / tt) * (1.f / 64.f);
            __hip_atomic_store((float*)(barw + 8), V, __ATOMIC_RELAXED, __HIP_MEMORY_SCOPE_AGENT); }
#endif
#ifdef PROBE_F1
        if (l == DEPTH - 1 && bx == 0 && tid == 0) { STAMP(5);
            const float f1 = (float)pT1 / (float)ptot, f2 = (float)pT2 / (float)ptot; const float V = floorf(f1 * 64.f) * (1.f / 64.f) + f2 * (1.f / 64.f);
            __hip_atomic_store((float*)(barw + 8), V, __ATOMIC_RELAXED, __HIP_MEMORY_SCOPE_AGENT); }
#endif
        xcd_barrier(xbar, bar_nloc, bar_nx);
        STAMP(5);
    }
    {
    int tidf = threadIdx.x; asm volatile("" : "+v"(tidf));
    const int lane = tidf & 63, gw = bx * 8 + __builtin_amdgcn_readfirstlane(tidf >> 6);
    for (int row = gw; row < M_TOT; row += NGW) {
        float s = (lane < 16) ? ssq[(size_t)row * 16 + lane] : 0.f;
        s = wave_sum(s);
        const float rs = rsqrtf(s * (1.0f / D) + EPS);
        const bf16_t* xr = XB + (size_t)row * D; float* orow = out + (size_t)row * D;
#pragma unroll
        for (int j = 0; j < 4; ++j) { const u32x2 raw = *(const u32x2*)(xr + 4 * lane + 256 * j); const f32x4 gv = *(const f32x4*)(a.norm_final + 4 * lane + 256 * j);
            const f32x4 v = (f32x4){__uint_as_float(raw.x << 16), __uint_as_float(raw.x & 0xffff0000u), __uint_as_float(raw.y << 16), __uint_as_float(raw.y & 0xffff0000u)};
            f32x4 ov = v * rs * gv;
#if defined(PROBE_F1) || defined(PROBE_NA)
            { const float dl = sqrtf(__hip_atomic_load((float*)(barw + 8), __ATOMIC_RELAXED, __HIP_MEMORY_SCOPE_AGENT) * 4e-4f); ov += (f32x4){dl, -dl, dl, -dl}; }
#endif
            *(f32x4*)(orow + 4 * lane + 256 * j) = ov; }
    }
    }
}

extern "C" void kernel_launch(void* const* d_in, const int* in_sizes, int n_in, void* d_out, int out_size, void* d_ws, size_t ws_size, hipStream_t stream) {
    static int grid = 0;
    if (grid == 0) {
        if (n_in != 11 || out_size != M_TOT * D || ws_size < WS_END) { fprintf(stderr, "kernel_launch: unexpected shapes (n_in %d out %d ws %zu)\n", n_in, out_size, ws_size); grid = -1; return; }
        int dev = 0, cus = 0, per_cu = 0;
        hipGetDevice(&dev);
        hipDeviceGetAttribute(&cus, hipDeviceAttributeMultiprocessorCount, dev);
        hipFuncSetAttribute((const void*)mega_fwd, hipFuncAttributeMaxDynamicSharedMemorySize, LDS_BYTES);
        hipOccupancyMaxActiveBlocksPerMultiprocessor(&per_cu, (const void*)mega_fwd, 512, LDS_BYTES);
        if (per_cu < 1) { fprintf(stderr, "kernel_launch: occupancy query says %d blocks per CU\n", per_cu); per_cu = 1; }
        (void)hipGetLastError();
        grid = cus * 1;
    }
    if (grid < 0) return;
    Args a{};
    a.xp = (const float*)d_in[0]; a.xs = (const float*)d_in[1]; a.norm_mix = (const float*)d_in[2]; a.w_in = (const float*)d_in[3]; a.rpb = (const float*)d_in[4];
    a.sink = (const float*)d_in[5]; a.w_out = (const float*)d_in[6]; a.norm_mlp = (const float*)d_in[7]; a.w_up = (const float*)d_in[8]; a.w_down = (const float*)d_in[9];
    a.norm_final = (const float*)d_in[10]; a.out = (float*)d_out; a.ws = (unsigned char*)d_ws;
    for (int i = 0; i < 32; ++i) a.inv_freq[i] = (float)pow(10000.0, -(double)i / 32.0);
    void* args[] = {&a};
    hipError_t e = hipLaunchCooperativeKernel((const void*)mega_fwd, dim3(grid), dim3(512), args, LDS_BYTES, stream);
    if (e != hipSuccess) fprintf(stderr, "kernel_launch: cooperative launch failed: %s (grid %d)\n", hipGetErrorString(e), grid);
}
```
